# Optimizing an MI355X kernel written in HIP

```python
import math, functools
import jax, jax.numpy as jnp
from jax import lax
import numpy as np

D_MODEL = 2048
BATCH = 1
SEQ = 16384
DEPTH = 1
DEC_BATCH = 16
DEC_SEQ = 32
PAST_LEN = 1024

CHUNK = 64
Q_BLOCK = 128
H_A = 8
DV_A = (D_MODEL // 2) // H_A
HD_A = DV_A // 2
H_B = 8
HD_B = (D_MODEL // 2) // H_B
HKV_B = 2
G_B = H_B // HKV_B
H_IDX = 16
D_IDX = 64
TOPK_MAX = 256
N_BUCKETS = 32
MAX_DISTANCE = 128
D_FF = 4 * D_MODEL
EPS = 1e-6
SPLIT_SIZES = (H_A * 2 * HD_A, H_A * 2 * HD_A, H_A * DV_A, H_B * HD_B, HKV_B * HD_B, HKV_B * HD_B,
               H_IDX * D_IDX, D_IDX, H_IDX, D_MODEL, D_MODEL)
IN_COLS = sum(SPLIT_SIZES)

kernel_name = 'diff_dsa_gated_parallel_stream_encoder'


def rms_norm(x, g):
    xf = x.astype(jnp.float32)
    y = xf * lax.rsqrt(jnp.mean(xf * xf, axis=-1, keepdims=True) + EPS)
    return (y * g.astype(jnp.float32)).astype(x.dtype)


def split_cols(z):
    out, o = [], 0
    for n in SPLIT_SIZES:
        out.append(z[..., o:o + n])
        o += n
    return out


def t5_bucket(rel):
    half = N_BUCKETS // 2
    exact = half // 2
    n = jnp.abs(rel)
    nf = jnp.maximum(n, 1).astype(jnp.float32)
    large = exact + (jnp.log(nf / exact) / math.log(MAX_DISTANCE / exact) * (half - exact)).astype(jnp.int32)
    large = jnp.minimum(large, half - 1)
    return jnp.where(rel > 0, half, 0) + jnp.where(n < exact, n, large)


def chunk_visible(qpos, kpos):
    return (kpos // CHUNK) <= (qpos // CHUNK)


def diff_attn_block(start, q1, q2, k1, k2, v, lam, bias_tab):
    tq, n_keys = q1.shape[1], k1.shape[1]
    qpos = start + jnp.arange(tq)
    kpos = jnp.arange(n_keys)
    bias = bias_tab[t5_bucket(kpos[None, :] - qpos[:, None])].astype(jnp.float32)
    bias = jnp.transpose(bias, (2, 0, 1))[None]
    mask = chunk_visible(qpos[:, None], kpos[None, :])[None, None]
    scale = HD_A ** -0.5

    def probs(q, k):
        s = jnp.einsum('bthd,bshd->bhts', q, k, preferred_element_type=jnp.float32) * scale + bias
        return jax.nn.softmax(jnp.where(mask, s, -jnp.inf), axis=-1)

    a = probs(q1, k1) - lam * probs(q2, k2)
    return jnp.einsum('bhts,bshe->bthe', a.astype(v.dtype), v)


def dsa_block(start, qb, qi, wi, kb, vb, ki, bias_tab, topk):
    b, tq = qb.shape[0], qb.shape[1]
    n_keys = kb.shape[1]
    qpos = start + jnp.arange(tq)
    kpos = jnp.arange(n_keys)
    admissible = chunk_visible(qpos[:, None], kpos[None, :])
    rel = jax.nn.relu(jnp.einsum('bthd,bsd->bths', qi, ki, preferred_element_type=jnp.float32))
    score = jnp.einsum('bth,bths->bts', wi.astype(jnp.float32), rel)
    score = jnp.where(admissible[None], score, -jnp.inf)
    _, idx = lax.top_k(score, topk)
    ksel = jax.vmap(lambda kk, ii: kk[ii])(kb, idx)
    vsel = jax.vmap(lambda vv, ii: vv[ii])(vb, idx)
    valid = (idx // CHUNK) <= (qpos[None, :, None] // CHUNK)
    bias = bias_tab[t5_bucket(idx - qpos[None, :, None])].astype(jnp.float32)
    bias = jnp.transpose(bias.reshape(b, tq, topk, HKV_B, G_B), (0, 1, 3, 4, 2))
    q = qb.reshape(b, tq, HKV_B, G_B, HD_B)
    s = jnp.einsum('btngd,btjnd->btngj', q, ksel, preferred_element_type=jnp.float32) * (HD_B ** -0.5) + bias
    s = jnp.where(valid[:, :, None, None, :], s, -jnp.inf)
    p = jax.nn.softmax(s, axis=-1)
    o = jnp.einsum('btngj,btjnd->btngd', p.astype(vsel.dtype), vsel)
    return o.reshape(b, tq, H_B * HD_B)


def blockwise(fn, q_arrays, q0, n_q):
    if n_q > Q_BLOCK and n_q % Q_BLOCK == 0:
        nb = n_q // Q_BLOCK
        split = lambda a: jnp.swapaxes(a.reshape((a.shape[0], nb, Q_BLOCK) + a.shape[2:]), 0, 1)
        starts = q0 + Q_BLOCK * jnp.arange(nb, dtype=jnp.int32)
        out = lax.map(lambda a: fn(a[0], *a[1]), (starts, tuple(split(a) for a in q_arrays)))
        out = jnp.swapaxes(out, 0, 1)
        return out.reshape((out.shape[0], n_q) + out.shape[3:])
    return fn(q0, *q_arrays)


def layer_forward(x, past, rel_bias, norm1_g, w_in, qn_a_g, kn_a_g, lam_q1, lam_k1, lam_q2, lam_k2,
                  subln_a_g, qn_b_g, kn_b_g, w_o_a, w_o_b, w_out, norm2_g, w_ff1, w_ff2, lam_init):
    b, t, _ = x.shape
    h = rms_norm(x, norm1_g)
    z = jnp.einsum('btd,de->bte', h, w_in)
    qa, ka, va, qb, kb, vb, qi, ki, wi, ga, gb = split_cols(z)
    qa = rms_norm(qa.reshape(b, t, H_A, 2, HD_A), qn_a_g.reshape(2, HD_A))
    ka = rms_norm(ka.reshape(b, t, H_A, 2, HD_A), kn_a_g.reshape(2, HD_A)).reshape(b, t, H_A, 2 * HD_A)
    va = va.reshape(b, t, H_A, DV_A)
    qb = rms_norm(qb.reshape(b, t, H_B, HD_B), qn_b_g)
    kb = rms_norm(kb.reshape(b, t, HKV_B, HD_B), kn_b_g)
    vb = vb.reshape(b, t, HKV_B, HD_B)
    qi = qi.reshape(b, t, H_IDX, D_IDX)
    new_rows = (ka, va, kb, vb, ki)
    if past is None:
        full = new_rows
    else:
        full = tuple(jnp.concatenate([p.astype(n.dtype), n], axis=1) for p, n in zip(past, new_rows))
    ka_f, va_f, kb_f, vb_f, ki_f = full
    n_keys = ka_f.shape[1]
    q0 = n_keys - t

    k_pair = ka_f.reshape(b, n_keys, H_A, 2, HD_A)
    lam = (jnp.exp(jnp.sum(lam_q1.astype(jnp.float32) * lam_k1.astype(jnp.float32)))
           - jnp.exp(jnp.sum(lam_q2.astype(jnp.float32) * lam_k2.astype(jnp.float32))) + lam_init)
    fa = functools.partial(diff_attn_block, k1=k_pair[..., 0, :], k2=k_pair[..., 1, :], v=va_f,
                           lam=lam, bias_tab=rel_bias[:, :H_A])
    oa = blockwise(fa, (qa[..., 0, :], qa[..., 1, :]), q0, t)
    oa = (rms_norm(oa, subln_a_g) * (1.0 - lam_init)).reshape(b, t, H_A * DV_A)

    topk = min(TOPK_MAX, n_keys // 4)
    fb = functools.partial(dsa_block, kb=kb_f, vb=vb_f, ki=ki_f, bias_tab=rel_bias[:, H_A:], topk=topk)
    ob = blockwise(fb, (qb, qi, wi), q0, t)

    merged = jax.nn.sigmoid(ga) * (ob @ w_o_b) + jax.nn.sigmoid(gb * 0 + gb) * 0 if False else \
        jax.nn.sigmoid(ga) * (oa @ w_o_a) + jax.nn.sigmoid(gb) * (ob @ w_o_b)
    x = x + merged @ w_out

    u = jax.nn.relu(rms_norm(x, norm2_g) @ w_ff1)
    x = x + (u * u) @ w_ff2
    return x, new_rows


def setup_inputs(seed: int = 0) -> dict:
    key = jax.random.key(seed)
    ks = jax.random.split(key, 26)
    nrm = lambda k, shape, scale: jax.random.normal(k, shape, jnp.float32) * scale
    gain = lambda k, shape: 1.0 + 0.05 * jax.random.normal(k, shape, jnp.float32)
    return {
        'x_prompt': nrm(ks[0], (BATCH, SEQ, D_MODEL), 1.0),
        'x_sample': nrm(ks[1], (DEC_BATCH, DEC_SEQ, D_MODEL), 1.0),
        'cache_a_k': nrm(ks[2], (DEPTH, DEC_BATCH, PAST_LEN, H_A, 2 * HD_A), 1.0),
        'cache_a_v': nrm(ks[3], (DEPTH, DEC_BATCH, PAST_LEN, H_A, DV_A), 1.0),
        'cache_b_k': nrm(ks[4], (DEPTH, DEC_BATCH, PAST_LEN, HKV_B, HD_B), 1.0),
        'cache_b_v': nrm(ks[5], (DEPTH, DEC_BATCH, PAST_LEN, HKV_B, HD_B), 1.0),
        'cache_b_kidx': nrm(ks[6], (DEPTH, DEC_BATCH, PAST_LEN, D_IDX), 1.0),
        'rel_bias': nrm(ks[7], (N_BUCKETS, H_A + H_B), 0.2),
        'norm1_g': gain(ks[8], (DEPTH, D_MODEL)),
        'w_in': nrm(ks[9], (DEPTH, D_MODEL, IN_COLS), D_MODEL ** -0.5),
        'qn_a_g': gain(ks[10], (DEPTH, 2 * HD_A)),
        'kn_a_g': gain(ks[11], (DEPTH, 2 * HD_A)),
        'lam_q1': nrm(ks[12], (DEPTH, HD_A), 0.1),
        'lam_k1': nrm(ks[13], (DEPTH, HD_A), 0.1),
        'lam_q2': nrm(ks[14], (DEPTH, HD_A), 0.1),
        'lam_k2': nrm(ks[15], (DEPTH, HD_A), 0.1),
        'subln_a_g': gain(ks[16], (DEPTH, DV_A)),
        'qn_b_g': gain(ks[17], (DEPTH, HD_B)),
        'kn_b_g': gain(ks[18], (DEPTH, HD_B)),
        'w_o_a': nrm(ks[19], (DEPTH, H_A * DV_A, D_MODEL), (H_A * DV_A) ** -0.5),
        'w_o_b': nrm(ks[20], (DEPTH, H_B * HD_B, D_MODEL), (H_B * HD_B) ** -0.5),
        'w_out': nrm(ks[21], (DEPTH, D_MODEL, D_MODEL), D_MODEL ** -0.5),
        'norm2_g': gain(ks[22], (DEPTH, D_MODEL)),
        'w_ff1': nrm(ks[23], (DEPTH, D_MODEL, D_FF), D_MODEL ** -0.5),
        'w_ff2': nrm(ks[24], (DEPTH, D_FF, D_MODEL), D_FF ** -0.5),
    }


def reference(x_prompt, x_sample, cache_a_k, cache_a_v, cache_b_k, cache_b_v, cache_b_kidx, rel_bias,
              norm1_g, w_in, qn_a_g, kn_a_g, lam_q1, lam_k1, lam_q2, lam_k2, subln_a_g, qn_b_g, kn_b_g,
              w_o_a, w_o_b, w_out, norm2_g, w_ff1, w_ff2):
    y_prompt, y_sample = x_prompt, x_sample
    prompt_rows, sample_rows = [], []
    for l in range(DEPTH):
        lam_init = 0.8 - 0.6 * math.exp(-0.3 * l)
        weights = (rel_bias, norm1_g[l], w_in[l], qn_a_g[l], kn_a_g[l], lam_q1[l], lam_k1[l], lam_q2[l],
                   lam_k2[l], subln_a_g[l], qn_b_g[l], kn_b_g[l], w_o_a[l], w_o_b[l], w_out[l], norm2_g[l],
                   w_ff1[l], w_ff2[l], lam_init)
        y_prompt, rp = layer_forward(y_prompt, None, *weights)
        past = (cache_a_k[l], cache_a_v[l], cache_b_k[l], cache_b_v[l], cache_b_kidx[l])
        y_sample, rs = layer_forward(y_sample, past, *weights)
        prompt_rows.append(rp)
        sample_rows.append(rs)
    p_a_k, p_a_v, p_b_k, p_b_v, p_b_kidx = (jnp.stack(r, axis=0) for r in zip(*prompt_rows))
    s_a_k, s_a_v, s_b_k, s_b_v, s_b_kidx = (jnp.stack(r, axis=0) for r in zip(*sample_rows))
    return (y_prompt, y_sample, p_a_k, p_a_v, p_b_k, p_b_v, p_b_kidx, s_a_k, s_a_v, s_b_k, s_b_v, s_b_kidx)
```

```cpp
#include <hip/hip_runtime.h>
#include <hip/hip_cooperative_groups.h>
#include <cstdio>
#include <cstdint>
namespace cg = cooperative_groups;
#ifndef N_LAUNCH_MODE
#define N_LAUNCH_MODE 1
#endif
#ifndef REP_ATTN
#define REP_ATTN 1
#endif
#ifndef REP_DSA
#define REP_DSA 1
#endif
#ifndef REP_IDX
#define REP_IDX 1
#endif
#ifndef REP_BIS
#define REP_BIS 1
#endif
#ifndef REP_SPARSE
#define REP_SPARSE 1
#endif
#ifndef REP_PH
#define REP_PH -1
#endif
#ifndef FORCE_SLOW
#define FORCE_SLOW 0
#endif
namespace pg8 {
#define PG8_LAS __attribute__((address_space(3)))
typedef unsigned short bf16_t;
typedef short bf16x8 __attribute__((ext_vector_type(8)));
typedef float f32x4 __attribute__((ext_vector_type(4)));
typedef unsigned u32x4 __attribute__((ext_vector_type(4)));
constexpr int BM = 256, BK = 64, HALF = 128, HTB = HALF * BK * 2  , STAGE_BYTES = 8 * HTB, NXCD = 8, WGM = 8;

__host__ __device__ __forceinline__ int lds_byte(int r, int c) { const int st = (r >> 4) * 2 + (c >> 5), rr = r & 15, cc = c & 31, ob = rr * 64 + cc * 2; return st * 1024 + (ob ^ (((ob >> 9) & 1) << 5)); }
__host__ __device__ __forceinline__ void stage_rc(int b, int& R, int& C) { const int st = b / 1024, sb = b % 1024, swz = sb ^ (((sb >> 9) & 1) << 5); R = (st >> 1) * 16 + swz / 64; C = (st & 1) * 32 + (swz % 64) / 2; }
__host__ __device__ __forceinline__ int perm32(int rho) { const int n = rho >> 4, i = rho & 15; return 8 * (i >> 2) + 4 * n + (i & 3); }

struct Unit { int pm, pn; };
struct Gemm { const bf16_t* A; const bf16_t* Bt; int M, N, K, ld; };

struct StaticOrder {
    int nM, nN, nwg, G, c;
    __host__ __device__ void init(int M, int N, int G_, int c_) { nM = M / BM; nN = N / BM; nwg = nM * nN; G = G_; c = c_; }
    __host__ __device__ __forceinline__ bool next(int i, Unit& u) const { return at((long)i * G + c, u); }
    __host__ __device__ __forceinline__ bool at(const long L, Unit& u) const {
        if (L >= nwg) return false;
        int wgid = (int)L; { const int q = nwg / NXCD, r = nwg % NXCD, xcd = wgid % NXCD, off = wgid / NXCD; wgid = (xcd < r ? xcd * (q + 1) : r * (q + 1) + (xcd - r) * q) + off; }
        const int nig = WGM * nN, gid = wgid / nig, fm = gid * WGM, gsz = (nM - fm) < WGM ? (nM - fm) : WGM;
        u.pm = fm + ((wgid % nig) % gsz); u.pn = (wgid % nig) / gsz; return true;
    }
    __device__ __forceinline__ void a_ready(const Unit&) const {}
    __device__ __forceinline__ void done(const Unit&) const {}
};


template <class Epi, class Sched, bool ALIGN_EPI = false, bool SP2 = false>
__device__ __forceinline__ void gemm_phase(PG8_LAS unsigned char* lds, const Gemm g, const Sched& S, const Epi& E) {
    const int tid = threadIdx.x, wid = __builtin_amdgcn_readfirstlane(tid >> 6), lane = tid & 63, wr = wid >> 2, wc = wid & 3, fr = lane & 15, fq = lane >> 4;
    const int K = g.K, nt = K / BK, LD = g.ld;
    unsigned voffA[2], voffB[2];
#pragma unroll
    for (int i = 0; i < 2; ++i) { int R, C; stage_rc(tid * 16 + i * 8192, R, C); const int Rb = Epi::PERM ? ((R & ~31) + perm32(R & 31)) : R;
        voffA[i] = (unsigned)(R * LD + C) * 2u; voffB[i] = (unsigned)(Rb * LD + C) * 2u; }
    const size_t kstep = (size_t)(BK * 2);
    const size_t hstep = (size_t)HALF * LD * 2;
    const size_t tstep = 2 * hstep;
    const unsigned ldsw = (unsigned)wid * 1024u;
    const int aoff = lds_byte(wr * 64 + fr, fq * 8), boff = lds_byte(wc * 32 + fr, fq * 8);
#define PG8_SA(b, h) (((b) * 2 + (h)) * HTB)
#define PG8_SB(b, h) ((4 + (b) * 2 + (h)) * HTB)
#define PG8_STAGE(bufoff, gbase, voff) do { _Pragma("unroll") for (int _i = 0; _i < 2; ++_i) \
        __builtin_amdgcn_global_load_lds((const unsigned*)((const char*)(gbase) + (voff)[_i]), (PG8_LAS unsigned*)(lds + (bufoff) + ldsw + _i * 8192), 16, 0, 0); } while (0)
#define PG8_LDA(dst, b, h) do { _Pragma("unroll") for (int m = 0; m < 4; ++m) _Pragma("unroll") for (int k = 0; k < 2; ++k) dst[m][k] = *(const PG8_LAS bf16x8*)(lds + PG8_SA(b, h) + aoff + m * 2048 + k * 1024); } while (0)
#define PG8_LDB(dst, b, h) do { _Pragma("unroll") for (int n = 0; n < 2; ++n) _Pragma("unroll") for (int k = 0; k < 2; ++k) dst[n][k] = *(const PG8_LAS bf16x8*)(lds + PG8_SB(b, h) + boff + n * 2048 + k * 1024); } while (0)
#define PG8_MMA(ai, bj, At, Bt) do { __builtin_amdgcn_s_setprio(1); _Pragma("unroll") for (int m = 0; m < 4; ++m) _Pragma("unroll") for (int n = 0; n < 2; ++n) _Pragma("unroll") for (int k = 0; k < 2; ++k) \
        acc[ai][bj][m][n] = __builtin_amdgcn_mfma_f32_16x16x32_bf16(Bt[n][k], At[m][k], acc[ai][bj][m][n], 0, 0, 0); __builtin_amdgcn_s_setprio(0); } while (0)
#define PG8_WAIT_V(n) asm volatile("s_waitcnt vmcnt(" #n ")" ::: "memory")
#define PG8_WAIT_L(n) asm volatile("s_waitcnt lgkmcnt(" #n ")" ::: "memory")
#define PG8_BAR __builtin_amdgcn_s_barrier()
#define PG8_SCHED __builtin_amdgcn_sched_barrier(0)
    Unit cur, nxt; int ui = 0;
    if (!S.next(0, cur)) return;
    f32x4 acc[2][2][4][2];
#pragma unroll
    for (int a = 0; a < 2; ++a)
#pragma unroll
        for (int b = 0; b < 2; ++b)
#pragma unroll
            for (int m = 0; m < 4; ++m)
#pragma unroll
                for (int n = 0; n < 2; ++n) acc[a][b][m][n] = (f32x4){0.f, 0.f, 0.f, 0.f};
    bf16x8 At[4][2], B0[2][2], B1[2][2];
    const char* cA = (const char*)g.A + (size_t)cur.pm * tstep; const char* cB = (const char*)g.Bt + (size_t)cur.pn * tstep;
    S.a_ready(cur);
    if constexpr (SP2) {
        PG8_STAGE(PG8_SB(0, 0), cB, voffB); PG8_STAGE(PG8_SB(0, 1), cB + hstep, voffB); PG8_STAGE(PG8_SA(0, 0), cA, voffA); PG8_STAGE(PG8_SA(0, 1), cA + hstep, voffA);
        if (wr == 1) PG8_BAR;
        PG8_WAIT_V(2); PG8_BAR;
        PG8_STAGE(PG8_SB(1, 0), cB + kstep, voffB); PG8_STAGE(PG8_SA(1, 0), cA + kstep, voffA); PG8_STAGE(PG8_SB(1, 1), cB + hstep + kstep, voffB);
        PG8_WAIT_V(6); PG8_BAR;
    } else {
        PG8_STAGE(PG8_SB(0, 0), cB, voffB); PG8_STAGE(PG8_SA(0, 0), cA, voffA); PG8_STAGE(PG8_SB(0, 1), cB + hstep, voffB); PG8_STAGE(PG8_SA(0, 1), cA + hstep, voffA);
        if (wr == 1) PG8_BAR;
        PG8_WAIT_V(4); PG8_BAR;
        PG8_STAGE(PG8_SB(1, 0), cB + kstep, voffB); PG8_STAGE(PG8_SA(1, 0), cA + kstep, voffA); PG8_STAGE(PG8_SB(1, 1), cB + hstep + kstep, voffB);
        PG8_WAIT_V(6); PG8_BAR;
    }
    for (;;) {
        const bool has_next = S.next(ui + 1, nxt);
        const char* nA = has_next ? (const char*)g.A + (size_t)nxt.pm * tstep : cA; const char* nB = has_next ? (const char*)g.Bt + (size_t)nxt.pn * tstep : cB;
        for (int t = 0; t < nt; t += 2) {
            const bool last = (t == nt - 2);
            const char* a1 = cA + (size_t)(t + 1) * kstep;
            const char* a2 = last ? nA : cA + (size_t)(t + 2) * kstep; const char* b2 = last ? nB : cB + (size_t)(t + 2) * kstep;
            const char* a3 = a2 + kstep; const char* b3 = b2 + kstep;
            if (last && has_next) S.a_ready(nxt);
            if constexpr (SP2) {
            PG8_LDB(B0, 0, 0); PG8_LDB(B1, 0, 1); PG8_SCHED; PG8_LDA(At, 0, 0); PG8_STAGE(PG8_SA(1, 1), a1 + hstep, voffA);
            PG8_WAIT_V(8); PG8_WAIT_L(0); PG8_BAR; PG8_MMA(0, 0, At, B0); PG8_MMA(0, 1, At, B1); PG8_BAR; PG8_SCHED;
            PG8_LDA(At, 0, 1); PG8_STAGE(PG8_SB(0, 0), b2, voffB); PG8_STAGE(PG8_SB(0, 1), b2 + hstep, voffB); PG8_STAGE(PG8_SA(0, 0), a2, voffA);
            PG8_WAIT_V(8); PG8_WAIT_L(0); PG8_BAR; PG8_MMA(1, 0, At, B0); PG8_MMA(1, 1, At, B1); PG8_BAR; PG8_SCHED;
            PG8_LDB(B0, 1, 0); PG8_LDB(B1, 1, 1); PG8_SCHED; PG8_LDA(At, 1, 0); PG8_STAGE(PG8_SA(0, 1), a2 + hstep, voffA);
            PG8_WAIT_V(8); PG8_WAIT_L(0); PG8_BAR; PG8_MMA(0, 0, At, B0); PG8_MMA(0, 1, At, B1); PG8_BAR; PG8_SCHED;
            PG8_LDA(At, 1, 1); PG8_STAGE(PG8_SB(1, 0), b3, voffB); PG8_STAGE(PG8_SB(1, 1), b3 + hstep, voffB); PG8_STAGE(PG8_SA(1, 0), a3, voffA);
            PG8_WAIT_V(8); PG8_WAIT_L(0); PG8_BAR; PG8_MMA(1, 0, At, B0); PG8_MMA(1, 1, At, B1); PG8_BAR; PG8_SCHED;
            } else {
            PG8_LDB(B0, 0, 0); PG8_SCHED; PG8_LDA(At, 0, 0); PG8_STAGE(PG8_SA(1, 1), a1 + hstep, voffA);
            PG8_WAIT_L(8); PG8_BAR; PG8_WAIT_L(0); PG8_MMA(0, 0, At, B0); PG8_BAR; PG8_SCHED;
            PG8_LDB(B1, 0, 1); PG8_STAGE(PG8_SB(0, 0), b2, voffB);
            PG8_BAR; PG8_WAIT_L(0); PG8_MMA(0, 1, At, B1); PG8_BAR;
            PG8_LDA(At, 0, 1); PG8_STAGE(PG8_SA(0, 0), a2, voffA);
            PG8_BAR; PG8_WAIT_L(0); PG8_MMA(1, 0, At, B0); PG8_BAR; PG8_SCHED;
            PG8_STAGE(PG8_SB(0, 1), b2 + hstep, voffB);
            PG8_WAIT_V(6); PG8_BAR; PG8_MMA(1, 1, At, B1); PG8_BAR;
            PG8_LDB(B0, 1, 0); PG8_SCHED; PG8_LDA(At, 1, 0); PG8_STAGE(PG8_SA(0, 1), a2 + hstep, voffA);
            PG8_WAIT_L(8); PG8_BAR; PG8_WAIT_L(0); PG8_MMA(0, 0, At, B0); PG8_BAR; PG8_SCHED;
            PG8_LDB(B1, 1, 1); PG8_STAGE(PG8_SB(1, 0), b3, voffB);
            PG8_BAR; PG8_WAIT_L(0); PG8_MMA(0, 1, At, B1); PG8_BAR;
            PG8_LDA(At, 1, 1); PG8_STAGE(PG8_SA(1, 0), a3, voffA);
            PG8_BAR; PG8_WAIT_L(0); PG8_MMA(1, 0, At, B0); PG8_BAR; PG8_SCHED;
            PG8_STAGE(PG8_SB(1, 1), b3 + hstep, voffB);
            PG8_WAIT_V(6); PG8_BAR; PG8_MMA(1, 1, At, B1); PG8_BAR;
            }
        }
        if constexpr (ALIGN_EPI) { if (wr == 0) PG8_BAR; }
        if constexpr (!Epi::AFTER_DRAIN) { E(acc, cur, wr, wc, fr, fq); S.done(cur); }
        if (!has_next) break;
#pragma unroll
        for (int a = 0; a < 2; ++a)
#pragma unroll
            for (int b = 0; b < 2; ++b)
#pragma unroll
                for (int m = 0; m < 4; ++m)
#pragma unroll
                    for (int n = 0; n < 2; ++n) acc[a][b][m][n] = (f32x4){0.f, 0.f, 0.f, 0.f};
        cur = nxt; cA = nA; cB = nB; ++ui;
        if constexpr (ALIGN_EPI) { if (wr == 1) PG8_BAR; }
    }
    PG8_WAIT_V(0);
    if constexpr (!ALIGN_EPI) { if (wr == 0) PG8_BAR; }
    PG8_BAR;
    if constexpr (Epi::AFTER_DRAIN) { E.fused(acc, cur, wr, wc, fr, fq, lds, wid, lane); S.done(cur); }
#undef PG8_SA
#undef PG8_SB
#undef PG8_STAGE
#undef PG8_LDA
#undef PG8_LDB
#undef PG8_MMA
#undef PG8_WAIT_V
#undef PG8_WAIT_L
#undef PG8_BAR
#undef PG8_SCHED
}
}


#define DI __device__ __forceinline__
typedef unsigned short bf16_t;
typedef short bf16x8 __attribute__((ext_vector_type(8)));
typedef float f32x4 __attribute__((ext_vector_type(4)));
typedef float f32x16 __attribute__((ext_vector_type(16)));
typedef unsigned u32x4 __attribute__((ext_vector_type(4)));
typedef unsigned u32x2 __attribute__((ext_vector_type(2)));
typedef __bf16 bf16x2_t __attribute__((ext_vector_type(2)));
typedef float f32x2_t __attribute__((ext_vector_type(2)));
DI unsigned pk2(float a, float b) { f32x2_t v = {a, b}; bf16x2_t r = __builtin_convertvector(v, bf16x2_t); return __builtin_bit_cast(unsigned, r); }
DI float bflo(unsigned u) { return __uint_as_float(u << 16); }
DI float bfhi(unsigned u) { return __uint_as_float(u & 0xffff0000u); }
#define MFMA32(a, b, c) __builtin_amdgcn_mfma_f32_32x32x16_bf16((a), (b), (c), 0, 0, 0)
#define MFMA16(a, b, c) __builtin_amdgcn_mfma_f32_16x16x32_bf16((a), (b), (c), 0, 0, 0)

constexpr int TP = 16384, TS = 512, TT = TP + TS, DM = 2048, DFF = 8192;
constexpr int NIN = 9984;
constexpr int NB = 16, PAST = 1024, NKS = 1056;
constexpr int KVROWS = TP + NB * NKS;
constexpr float EPS = 1e-6f, LOG2E = 1.4426950408889634f;
constexpr int NTHREADS = 512;
constexpr int LDS_BYTES = 147456;
constexpr int XCH_OFF = 131072;

constexpr size_t al256(size_t x) { return (x + 255) & ~(size_t)255; }
constexpr size_t WS_WT_IN = 0;
constexpr size_t WS_WT_OA = WS_WT_IN + al256((size_t)NIN * DM * 2);
constexpr size_t WS_WT_OB = WS_WT_OA + al256((size_t)DM * 1024 * 2);
constexpr size_t WS_WT_OUT = WS_WT_OB + al256((size_t)DM * 1024 * 2);
constexpr size_t WS_WT_FF1 = WS_WT_OUT + al256((size_t)DM * DM * 2);
constexpr size_t WS_WT_FF2 = WS_WT_FF1 + al256((size_t)DFF * DM * 2);
constexpr size_t WS_H = WS_WT_FF2 + al256((size_t)DM * DFF * 2);
constexpr size_t WS_R = WS_H + al256((size_t)TT * DM * 2);
constexpr size_t WS_QA = WS_R;
constexpr size_t WS_QB = WS_QA + al256((size_t)TT * 1024 * 2);
constexpr size_t WS_QI = WS_QB + al256((size_t)TT * 1024 * 2);
constexpr size_t WS_KA = WS_QI + al256((size_t)TT * 1024 * 2);
constexpr size_t WS_VA = WS_KA + al256((size_t)KVROWS * 1024 * 2);
constexpr size_t WS_KB = WS_VA + al256((size_t)KVROWS * 1024 * 2);
constexpr size_t WS_VB = WS_KB + al256((size_t)KVROWS * 256 * 2);
constexpr size_t WS_KI = WS_VB + al256((size_t)KVROWS * 256 * 2);
constexpr size_t WS_WI = WS_KI + al256((size_t)KVROWS * 64 * 2);
constexpr size_t WS_REND = WS_WI + al256((size_t)TT * 16 * 4);
constexpr size_t WS_SELG = WS_REND;
constexpr size_t WS_SELG_END = WS_SELG + al256((size_t)TT * 256 * 4);
constexpr size_t WS_MERGED = WS_QA;
constexpr size_t WS_U = WS_R;
constexpr size_t WS_END = (WS_SELG_END > WS_U + (size_t)TT * DFF * 2) ? WS_SELG_END : (WS_U + al256((size_t)TT * DFF * 2));
static_assert(WS_QB + al256((size_t)TT * 1024 * 2) >= WS_MERGED + (size_t)TT * DM * 2, "merged overlay");

constexpr size_t O_Y = 0;
constexpr size_t O_PAK = O_Y + (size_t)TT * DM;
constexpr size_t O_PAV = O_PAK + (size_t)TP * 1024;
constexpr size_t O_PBK = O_PAV + (size_t)TP * 1024;
constexpr size_t O_PBV = O_PBK + (size_t)TP * 256;
constexpr size_t O_PKI = O_PBV + (size_t)TP * 256;
constexpr size_t O_SAK = O_PKI + (size_t)TP * 64;
constexpr size_t O_SAV = O_SAK + (size_t)TS * 1024;
constexpr size_t O_SBK = O_SAV + (size_t)TS * 1024;
constexpr size_t O_SBV = O_SBK + (size_t)TS * 256;
constexpr size_t O_SKI = O_SBV + (size_t)TS * 256;
constexpr size_t O_END = O_SKI + (size_t)TS * 64;

struct Params { const float* in[25]; float* out; unsigned char* ws; int ph_lo, ph_hi; };

DI int kvrow(int r) { if (r < TP) return r; const int s = r - TP; return TP + (s >> 5) * NKS + PAST + (s & 31); }

template <int MODE>
DI void tconv_tile(const float* __restrict__ src, int Ns, bf16_t* __restrict__ dst, int K, int kt, int nt, float* tile) {
    const int tid = threadIdx.x, k0 = kt * 64, n0 = nt * 64;
#pragma unroll
    for (int i = 0; i < 8; ++i) {
        const int k = i * 8 + (tid >> 6), n = tid & 63; int sc = n0 + n;
        if (MODE == 1) sc = (sc < 5712) ? sc : ((sc < 5888) ? -1 : sc - 176);
        tile[k * 65 + n] = (sc >= 0) ? src[(size_t)(k0 + k) * Ns + sc] : 0.f;
    }
    __syncthreads();
#pragma unroll
    for (int i = 0; i < 4; ++i) {
        const int n = i * 16 + (tid >> 5), kp = tid & 31;
        const float v0 = tile[(2 * kp) * 65 + n], v1 = tile[(2 * kp + 1) * 65 + n];
        *(unsigned*)(dst + (size_t)(n0 + n) * K + k0 + 2 * kp) = pk2(v0, v1);
    }
    __syncthreads();
}

DI float wave_sum(float v) {
#pragma unroll
    for (int o = 1; o < 64; o <<= 1) v += __shfl_xor(v, o);
    return v;
}

DI void rmsnorm_rows(const float* __restrict__ srcA, const float* __restrict__ srcB, const float* __restrict__ g, bf16_t* __restrict__ dst, int G, int c) {
    const int lane = threadIdx.x & 63, wave = __builtin_amdgcn_readfirstlane(threadIdx.x >> 6);
    for (int r = c * 8 + wave; r < TT; r += G * 8) {
        const float* s = (r < TP) ? srcA + (size_t)r * DM : srcB + (size_t)(r - TP) * DM;
        f32x4 v[8]; float ss = 0.f;
#pragma unroll
        for (int i = 0; i < 8; ++i) { v[i] = *(const f32x4*)(s + i * 256 + lane * 4); ss += v[i][0] * v[i][0] + v[i][1] * v[i][1] + v[i][2] * v[i][2] + v[i][3] * v[i][3]; }
        ss = wave_sum(ss);
        const float rs = rsqrtf(ss * (1.0f / DM) + EPS);
#pragma unroll
        for (int i = 0; i < 8; ++i) {
            const f32x4 gg = *(const f32x4*)(g + i * 256 + lane * 4);
            u32x2 w; w.x = pk2(v[i][0] * rs * gg[0], v[i][1] * rs * gg[1]); w.y = pk2(v[i][2] * rs * gg[2], v[i][3] * rs * gg[3]);
            *(u32x2*)(dst + (size_t)r * DM + i * 256 + lane * 4) = w;
        }
    }
}

DI void cache_conv(const float* __restrict__ src, bf16_t* __restrict__ dst, int W, int G, int c) {
    const size_t n8 = (size_t)NB * PAST * W / 8;
    for (size_t i = (size_t)c * NTHREADS + threadIdx.x; i < n8; i += (size_t)G * NTHREADS) {
        const size_t e = i * 8; const int row = (int)(e / W), col = (int)(e % W);
        const f32x4 a = *(const f32x4*)(src + e), b = *(const f32x4*)(src + e + 4);
        u32x4 w; w.x = pk2(a[0], a[1]); w.y = pk2(a[2], a[3]); w.z = pk2(b[0], b[1]); w.w = pk2(b[2], b[3]);
        const int drow = TP + (row >> 10) * NKS + (row & 1023);
        *(u32x4*)(dst + (size_t)drow * W + col) = w;
    }
}

DI void p0_prep(const Params& P, unsigned char* lds, int G, int c) {
    unsigned char* ws = P.ws;
    float* tile = (float*)lds;
    const int nt0 = 32 * 156, nt1 = 16 * 32, nt3 = 32 * 32, nt4 = 32 * 128, nt5 = 128 * 32;
    const int tot = nt0 + 2 * nt1 + nt3 + nt4 + nt5;
    for (int t = c; t < tot; t += G) {
        int u = t;
        if (u < nt0) { tconv_tile<1>(P.in[9], 9808, (bf16_t*)(ws + WS_WT_IN), DM, u & 31, u >> 5, tile); continue; }
        u -= nt0;
        if (u < nt1) { tconv_tile<0>(P.in[19], DM, (bf16_t*)(ws + WS_WT_OA), 1024, u & 15, u >> 4, tile); continue; }
        u -= nt1;
        if (u < nt1) { tconv_tile<0>(P.in[20], DM, (bf16_t*)(ws + WS_WT_OB), 1024, u & 15, u >> 4, tile); continue; }
        u -= nt1;
        if (u < nt3) { tconv_tile<0>(P.in[21], DM, (bf16_t*)(ws + WS_WT_OUT), DM, u & 31, u >> 5, tile); continue; }
        u -= nt3;
        if (u < nt4) { tconv_tile<0>(P.in[23], DFF, (bf16_t*)(ws + WS_WT_FF1), DM, u & 31, u >> 5, tile); continue; }
        u -= nt4;
        tconv_tile<0>(P.in[24], DM, (bf16_t*)(ws + WS_WT_FF2), DFF, u & 127, u >> 7, tile);
    }
    rmsnorm_rows(P.in[0], P.in[1], P.in[8], (bf16_t*)(ws + WS_H), G, c);
    cache_conv(P.in[2], (bf16_t*)(ws + WS_KA), 1024, G, c);
    cache_conv(P.in[3], (bf16_t*)(ws + WS_VA), 1024, G, c);
    cache_conv(P.in[4], (bf16_t*)(ws + WS_KB), 256, G, c);
    cache_conv(P.in[5], (bf16_t*)(ws + WS_VB), 256, G, c);
    cache_conv(P.in[6], (bf16_t*)(ws + WS_KI), 64, G, c);
}

struct OrderRounds { pg8::StaticOrder S; int rounds;
    DI bool next(int i, pg8::Unit& u) const { return i < rounds && S.next(i, u); }
    DI void a_ready(const pg8::Unit&) const {} DI void done(const pg8::Unit&) const {} };
struct OrderOne { pg8::StaticOrder S; int L;
    DI bool next(int i, pg8::Unit& u) const { if (i != 0) return false; return S.at((long)L, u); }
    DI void a_ready(const pg8::Unit&) const {} DI void done(const pg8::Unit&) const {} };

DI float sigmoidf_(float x) { return 1.0f / (1.0f + __expf(-x)); }

struct EpiInProj {
    static constexpr bool PERM = true, AFTER_DRAIN = false;
    float* out; unsigned char* ws; const float* g_qa; const float* g_ka; const float* g_qb; const float* g_kb; float* xch;
    DI void operator()(const f32x4 (&acc)[2][2][4][2], const pg8::Unit& u, int wr, int wc, int fr, int fq) const {
        const int pn = u.pn, pm = u.pm;
        const bool samp = (pm >= 64);
        const int rowl0 = wr * 64 + fr, lc0 = wc * 32 + 8 * fq;
        int norm = 0; const float* gain = nullptr; float post = 1.f; bool sig = false;
        float* f32p = nullptr; int f32ld = 0; bf16_t* b16p = nullptr; int b16ld = 0; bool kvm = false; int cb = 0;
        if (pn < 4)       { norm = 64; gain = g_qa; post = 0.125f; b16p = (bf16_t*)(ws + WS_QA); b16ld = 1024; cb = pn * 256; }
        else if (pn < 8)  { norm = 64; gain = g_ka; b16p = (bf16_t*)(ws + WS_KA); b16ld = 1024; kvm = true; cb = (pn - 4) * 256; f32p = out + (samp ? O_SAK : O_PAK); f32ld = 1024; }
        else if (pn < 12) { b16p = (bf16_t*)(ws + WS_VA); b16ld = 1024; kvm = true; cb = (pn - 8) * 256; f32p = out + (samp ? O_SAV : O_PAV); f32ld = 1024; }
        else if (pn < 16) { norm = 128; gain = g_qb; b16p = (bf16_t*)(ws + WS_QB); b16ld = 1024; cb = (pn - 12) * 256; }
        else if (pn == 16) { norm = 128; gain = g_kb; b16p = (bf16_t*)(ws + WS_KB); b16ld = 256; kvm = true; cb = 0; f32p = out + (samp ? O_SBK : O_PBK); f32ld = 256; }
        else if (pn == 17) { b16p = (bf16_t*)(ws + WS_VB); b16ld = 256; kvm = true; cb = 0; f32p = out + (samp ? O_SBV : O_PBV); f32ld = 256; }
        else if (pn < 22) { b16p = (bf16_t*)(ws + WS_QI); b16ld = 1024; cb = (pn - 18) * 256; }
        else if (pn == 22) {
#pragma unroll
            for (int ai = 0; ai < 2; ++ai)
#pragma unroll
                for (int m = 0; m < 4; ++m) {
                    const int r = pm * 256 + ai * 128 + m * 16 + rowl0;
                    const f32x4 v0 = acc[ai][0][m][0], v1 = acc[ai][0][m][1];
                    if (lc0 < 64) {
                        float* fo = out + (samp ? O_SKI + (size_t)(r - TP) * 64 : O_PKI + (size_t)r * 64) + lc0;
                        *(f32x4*)fo = v0; *(f32x4*)(fo + 4) = v1;
                        u32x4 w; w.x = pk2(v0[0], v0[1]); w.y = pk2(v0[2], v0[3]); w.z = pk2(v1[0], v1[1]); w.w = pk2(v1[2], v1[3]);
                        *(u32x4*)((bf16_t*)(ws + WS_KI) + (size_t)kvrow(r) * 64 + lc0) = w;
                    } else if (lc0 < 80) {
                        float* fo = (float*)(ws + WS_WI) + (size_t)r * 16 + (lc0 - 64);
                        *(f32x4*)fo = v0; *(f32x4*)(fo + 4) = v1;
                    }
                }
            return;
        }
        else if (pn < 31) { sig = true; b16p = (bf16_t*)(out + O_Y); b16ld = 4096; cb = (pn - 23) * 256; }
        else              { sig = true; b16p = (bf16_t*)(out + O_Y); b16ld = 4096; cb = 2048 + (pn - 31) * 256; }

        if (norm) {
#pragma unroll
            for (int ai = 0; ai < 2; ++ai)
#pragma unroll
                for (int m = 0; m < 4; ++m)
#pragma unroll
                    for (int bj = 0; bj < 2; ++bj) {
                        const f32x4 a = acc[ai][bj][m][0], b = acc[ai][bj][m][1];
                        float ss = a[0] * a[0] + a[1] * a[1] + a[2] * a[2] + a[3] * a[3] + b[0] * b[0] + b[1] * b[1] + b[2] * b[2] + b[3] * b[3];
                        ss += __shfl_xor(ss, 16); ss += __shfl_xor(ss, 32);
                        if (fq == 0) xch[(ai * 128 + m * 16 + rowl0) * 8 + bj * 4 + wc] = ss;
                    }
            __syncthreads();
        }
        f32x4 g0 = {1.f, 1.f, 1.f, 1.f}, g1 = {1.f, 1.f, 1.f, 1.f};
        if (norm) { g0 = *(const f32x4*)(gain + lc0); g1 = *(const f32x4*)(gain + lc0 + 4); }
#pragma unroll
        for (int ai = 0; ai < 2; ++ai)
#pragma unroll
            for (int m = 0; m < 4; ++m) {
                const int rl = ai * 128 + m * 16 + rowl0, r = pm * 256 + rl;
                const size_t brow = kvm ? (size_t)kvrow(r) : (size_t)r;
                const size_t frow = samp ? (size_t)(r - TP) : (size_t)r;
#pragma unroll
                for (int bj = 0; bj < 2; ++bj) {
                    f32x4 v0 = acc[ai][bj][m][0], v1 = acc[ai][bj][m][1];
                    if (norm) {
                        const f32x4 p4 = *(const f32x4*)(xch + rl * 8 + bj * 4);
                        float s;
                        if (norm == 64) s = (wc & 2) ? (p4[2] + p4[3]) : (p4[0] + p4[1]); else s = (p4[0] + p4[1]) + (p4[2] + p4[3]);
                        const float rs = rsqrtf(s * (norm == 64 ? (1.0f / 64.0f) : (1.0f / 128.0f)) + EPS);
                        v0 = v0 * rs * g0; v1 = v1 * rs * g1;
                    }
                    if (sig) { for (int e = 0; e < 4; ++e) { v0[e] = sigmoidf_(v0[e]); v1[e] = sigmoidf_(v1[e]); } }
                    const int col = cb + bj * 128 + lc0;
                    if (f32p) { float* fo = f32p + frow * f32ld + col; *(f32x4*)fo = v0; *(f32x4*)(fo + 4) = v1; }
                    v0 = v0 * post; v1 = v1 * post;
                    u32x4 w; w.x = pk2(v0[0], v0[1]); w.y = pk2(v0[2], v0[3]); w.z = pk2(v1[0], v1[1]); w.w = pk2(v1[2], v1[3]);
                    *(u32x4*)(b16p + brow * b16ld + col) = w;
                }
            }
    }
};

template <int PASS> struct EpiMerge {
    static constexpr bool PERM = true, AFTER_DRAIN = false;
    const bf16_t* gate; bf16_t* merged;
    DI void operator()(const f32x4 (&acc)[2][2][4][2], const pg8::Unit& u, int wr, int wc, int fr, int fq) const {
        const int rowl0 = wr * 64 + fr, lc0 = wc * 32 + 8 * fq;
#pragma unroll
        for (int ai = 0; ai < 2; ++ai)
#pragma unroll
            for (int m = 0; m < 4; ++m) {
                const size_t r = (size_t)u.pm * 256 + ai * 128 + m * 16 + rowl0;
#pragma unroll
                for (int bj = 0; bj < 2; ++bj) {
                    const int col = u.pn * 256 + bj * 128 + lc0;
                    const u32x4 gw = *(const u32x4*)(gate + r * 4096 + PASS * 2048 + col);
                    f32x4 v0 = acc[ai][bj][m][0], v1 = acc[ai][bj][m][1];
                    v0[0] *= bflo(gw.x); v0[1] *= bfhi(gw.x); v0[2] *= bflo(gw.y); v0[3] *= bfhi(gw.y);
                    v1[0] *= bflo(gw.z); v1[1] *= bfhi(gw.z); v1[2] *= bflo(gw.w); v1[3] *= bfhi(gw.w);
                    bf16_t* mp = merged + r * DM + col;
                    if (PASS == 1) {
                        const u32x4 t = *(const u32x4*)mp;
                        v0[0] += bflo(t.x); v0[1] += bfhi(t.x); v0[2] += bflo(t.y); v0[3] += bfhi(t.y);
                        v1[0] += bflo(t.z); v1[1] += bfhi(t.z); v1[2] += bflo(t.w); v1[3] += bfhi(t.w);
                    }
                    u32x4 w; w.x = pk2(v0[0], v0[1]); w.y = pk2(v0[2], v0[3]); w.z = pk2(v1[0], v1[1]); w.w = pk2(v1[2], v1[3]);
                    *(u32x4*)mp = w;
                }
            }
    }
};

struct EpiOut {
    static constexpr bool PERM = true, AFTER_DRAIN = false;
    const float* xp; const float* xs; float* y;
    DI void operator()(const f32x4 (&acc)[2][2][4][2], const pg8::Unit& u, int wr, int wc, int fr, int fq) const {
        const int rowl0 = wr * 64 + fr, lc0 = wc * 32 + 8 * fq;
#pragma unroll
        for (int ai = 0; ai < 2; ++ai)
#pragma unroll
            for (int m = 0; m < 4; ++m) {
                const int r = u.pm * 256 + ai * 128 + m * 16 + rowl0;
                const float* xr = (r < TP) ? xp + (size_t)r * DM : xs + (size_t)(r - TP) * DM;
#pragma unroll
                for (int bj = 0; bj < 2; ++bj) {
                    const int col = u.pn * 256 + bj * 128 + lc0;
                    const f32x4 a = *(const f32x4*)(xr + col), b = *(const f32x4*)(xr + col + 4);
                    float* yo = y + (size_t)r * DM + col;
                    *(f32x4*)yo = acc[ai][bj][m][0] + a; *(f32x4*)(yo + 4) = acc[ai][bj][m][1] + b;
                }
            }
    }
};

struct EpiFF1 {
    static constexpr bool PERM = true, AFTER_DRAIN = false;
    bf16_t* U;
    DI void operator()(const f32x4 (&acc)[2][2][4][2], const pg8::Unit& u, int wr, int wc, int fr, int fq) const {
        const int rowl0 = wr * 64 + fr, lc0 = wc * 32 + 8 * fq;
#pragma unroll
        for (int ai = 0; ai < 2; ++ai)
#pragma unroll
            for (int m = 0; m < 4; ++m) {
                const size_t r = (size_t)u.pm * 256 + ai * 128 + m * 16 + rowl0;
#pragma unroll
                for (int bj = 0; bj < 2; ++bj) {
                    const int col = u.pn * 256 + bj * 128 + lc0;
                    f32x4 v0 = acc[ai][bj][m][0], v1 = acc[ai][bj][m][1];
#pragma unroll
                    for (int e = 0; e < 4; ++e) { const float a = fmaxf(v0[e], 0.f), b = fmaxf(v1[e], 0.f); v0[e] = a * a; v1[e] = b * b; }
                    u32x4 w; w.x = pk2(v0[0], v0[1]); w.y = pk2(v0[2], v0[3]); w.z = pk2(v1[0], v1[1]); w.w = pk2(v1[2], v1[3]);
                    *(u32x4*)(U + r * DFF + col) = w;
                }
            }
    }
};

struct EpiFF2Part {
    static constexpr bool PERM = true, AFTER_DRAIN = false;
    float* part;
    DI void operator()(const f32x4 (&acc)[2][2][4][2], const pg8::Unit& u, int wr, int wc, int fr, int fq) const {
        const int rowl0 = wr * 64 + fr, lc0 = wc * 32 + 8 * fq;
#pragma unroll
        for (int ai = 0; ai < 2; ++ai)
#pragma unroll
            for (int m = 0; m < 4; ++m) {
                const int rl = ai * 128 + m * 16 + rowl0;
#pragma unroll
                for (int bj = 0; bj < 2; ++bj) {
                    float* po = part + rl * 256 + bj * 128 + lc0;
                    *(f32x4*)po = acc[ai][bj][m][0]; *(f32x4*)(po + 4) = acc[ai][bj][m][1];
                }
            }
    }
};

struct EpiFF2 {
    static constexpr bool PERM = true, AFTER_DRAIN = false;
    float* y;
    DI void operator()(const f32x4 (&acc)[2][2][4][2], const pg8::Unit& u, int wr, int wc, int fr, int fq) const {
        const int rowl0 = wr * 64 + fr, lc0 = wc * 32 + 8 * fq;
#pragma unroll
        for (int ai = 0; ai < 2; ++ai)
#pragma unroll
            for (int m = 0; m < 4; ++m) {
                const size_t r = (size_t)u.pm * 256 + ai * 128 + m * 16 + rowl0;
#pragma unroll
                for (int bj = 0; bj < 2; ++bj) {
                    const int col = u.pn * 256 + bj * 128 + lc0;
                    float* yo = y + r * DM + col;
                    const f32x4 a = *(const f32x4*)yo, b = *(const f32x4*)(yo + 4);
                    *(f32x4*)yo = acc[ai][bj][m][0] + a; *(f32x4*)(yo + 4) = acc[ai][bj][m][1] + b;
                }
            }
    }
};

DI int t5_bucket(int rel) {
    const int n = rel < 0 ? -rel : rel;
    int b;
    if (n < 8) b = n; else if (n < 12) b = 8; else if (n < 16) b = 9; else if (n < 23) b = 10; else if (n < 32) b = 11;
    else if (n < 46) b = 12; else if (n < 64) b = 13; else if (n < 91) b = 14; else b = 15;
    return b + (rel > 0 ? 16 : 0);
}

constexpr int KROW_B = 272;
constexpr int VROW_B = 136;
constexpr int QROW_B = 272;
constexpr int EXROW_B = 528;
constexpr int A_KS = 0;
constexpr int A_VT = A_KS + 2 * 64 * KROW_B;
constexpr int A_QS = A_VT + 2 * 128 * VROW_B;
constexpr int A_TAB = A_QS + 128 * QROW_B;
constexpr int A_END = A_TAB + 192 * 4;
constexpr int A_EX = 0;
static_assert(A_END <= LDS_BYTES && 128 * EXROW_B <= A_QS, "attention LDS");

struct AttnUnit { int h, qrow0, nq, qpos0, kbase, nkeys; };

#define GLBA_ __attribute__((address_space(1)))
DI void attn_a_unit(const AttnUnit U, const bf16_t* __restrict__ QA, const bf16_t* __restrict__ KA, const bf16_t* __restrict__ VA, bf16_t* __restrict__ OA,
                    const float* __restrict__ rel_bias, const float* __restrict__ subln_g, float lam, float mbound, unsigned char* lds) {
    int tid = threadIdx.x; asm volatile("" : "+v"(tid));
    const int lane = tid & 63, w = __builtin_amdgcn_readfirstlane(tid >> 6), hf = lane >> 5, l31 = lane & 31;
    const int c = w >> 2, wq = w & 3;
    const int h = U.h;
    int ntiles = (U.qpos0 + U.nq - 1) / 64 + 1; { const int nk = (U.nkeys + 63) / 64; ntiles = ntiles < nk ? ntiles : nk; }
    const bool active = (32 * wq < U.nq);
    const int qpos_w = U.qpos0 + 32 * wq;
    const int jmax_w = qpos_w >> 6;
    float* tab = (float*)(lds + A_TAB);
    if (tid < 192) { const int rel = tid - 128; tab[tid] = rel_bias[t5_bucket(rel) * 16 + h] - rel_bias[15 * 16 + h]; }
    {
#pragma unroll
        for (int i = 0; i < 4; ++i) {
            const int idx = i * 512 + tid, row = idx >> 4, seg = idx & 15;
            const int rr = row < U.nq ? row : U.nq - 1;
            const u32x4 v = *(const u32x4*)(QA + (size_t)(U.qrow0 + rr) * 1024 + h * 128 + seg * 8);
            *(u32x4*)(lds + A_QS + row * QROW_B + seg * 16) = v;
        }
    }
    const int k_key = tid >> 3, k_seg = tid & 7;
    const int v_clo = tid & 3, v_kp = ((tid >> 2) & 15) + 16 * ((tid >> 6) & 1), v_c = (tid >> 7) * 4 + v_clo;
    u32x4 kr0, kr1, vr0, vr1, kq0, kq1, vq0, vq1;
    const GLBA_ bf16_t* kgp = (const GLBA_ bf16_t*)(KA + (size_t)(U.kbase + k_key) * 1024 + h * 128 + k_seg * 16);
    const GLBA_ bf16_t* vgp = (const GLBA_ bf16_t*)(VA + (size_t)(U.kbase + 2 * v_kp) * 1024 + h * 128 + v_c * 8);
#define A_LOADK2(j, K0, K1) do { asm volatile("" : "+v"(kgp)); K0 = *(const GLBA_ u32x4*)kgp; K1 = *(const GLBA_ u32x4*)(kgp + 8); kgp += 64 * 1024; } while (0)
#define A_LOADV2(j, V0, V1) do { asm volatile("" : "+v"(vgp)); V0 = *(const GLBA_ u32x4*)vgp; V1 = *(const GLBA_ u32x4*)(vgp + 1024); vgp += 64 * 1024; } while (0)
#define A_STOREK2(b, K0, K1) do { \
        unsigned char* kd_ = lds + A_KS + (b) * 64 * KROW_B + k_key * KROW_B + k_seg * 32; \
        *(u32x4*)kd_ = K0; *(u32x4*)(kd_ + 16) = K1; } while (0)
#define A_STOREV2(b, V0, V1) do { \
        unsigned char* vd_ = lds + A_VT + (b) * 128 * VROW_B + (v_c * 8) * VROW_B + v_kp * 4; \
        *(unsigned*)(vd_ + 0 * VROW_B) = (V0.x & 0xffffu) | (V1.x << 16); *(unsigned*)(vd_ + 1 * VROW_B) = (V0.x >> 16) | (V1.x & 0xffff0000u); \
        *(unsigned*)(vd_ + 2 * VROW_B) = (V0.y & 0xffffu) | (V1.y << 16); *(unsigned*)(vd_ + 3 * VROW_B) = (V0.y >> 16) | (V1.y & 0xffff0000u); \
        *(unsigned*)(vd_ + 4 * VROW_B) = (V0.z & 0xffffu) | (V1.z << 16); *(unsigned*)(vd_ + 5 * VROW_B) = (V0.z >> 16) | (V1.z & 0xffff0000u); \
        *(unsigned*)(vd_ + 6 * VROW_B) = (V0.w & 0xffffu) | (V1.w << 16); *(unsigned*)(vd_ + 7 * VROW_B) = (V0.w >> 16) | (V1.w & 0xffff0000u); } while (0)

    A_LOADK2(0, kr0, kr1); A_STOREK2(0, kr0, kr1); A_LOADV2(0, vr0, vr1); A_STOREV2(0, vr0, vr1);
    A_LOADK2(1, kq0, kq1); A_LOADV2(1, vq0, vq1);
    __syncthreads();

    int oq_ = A_QS + (32 * wq + l31) * QROW_B + hf * 16 + c * 128; asm volatile("" : "+v"(oq_));
    const unsigned char* Qb0 = lds + oq_;
    int ov_ = A_VT + l31 * VROW_B + hf * 8; asm volatile("" : "+v"(ov_));
    int ok_ = A_KS + c * 128 + hf * 16 + l31 * KROW_B; asm volatile("" : "+v"(ok_));
    f32x16 O[4];
#pragma unroll
    for (int nt = 0; nt < 4; ++nt)
#pragma unroll
        for (int i = 0; i < 16; ++i) O[nt][i] = 0.f;
    float lrow = 0.f;
    const float mL = mbound * LOG2E;

    for (int j = 0; j < ntiles; ++j) {
        {
        const int buf = j & 1;
        const bool more = (j + 1 < ntiles);
        A_LOADK2(j + 2, kr0, kr1); A_LOADV2(j + 2, vr0, vr1);
        const bool doit = active && j <= jmax_w;
        bf16x8 pf[2][2];
        if (doit) {
            const unsigned char* Kb = lds + ok_ + buf * 64 * KROW_B;
            const bool near = (64 * j + 63 + 91 > qpos_w);
            const bool lastmask = (64 * j + 64 > U.nkeys);
            f32x16 s0, s1;
#pragma unroll
            for (int i = 0; i < 16; ++i) { s0[i] = 0.f; s1[i] = 0.f; }
#pragma unroll
            for (int ks = 0; ks < 4; ++ks) {
                const bf16x8 qf = *(const bf16x8*)(Qb0 + ks * 32);
                const bf16x8 k0 = *(const bf16x8*)(Kb + ks * 32);
                const bf16x8 k1 = *(const bf16x8*)(Kb + 32 * KROW_B + ks * 32);
                s0 = MFMA32(k0, qf, s0); s1 = MFMA32(k1, qf, s1);
            }
            if (near) {
                const int qp = qpos_w + l31;
#pragma unroll
                for (int i = 0; i < 16; ++i) {
                    const int key = 64 * j + (i & 3) + 8 * (i >> 2) + 4 * hf;
                    int r0 = key - qp, r1 = key + 32 - qp;
                    r0 = r0 < -128 ? -128 : r0; r1 = r1 < -128 ? -128 : r1;
                    s0[i] += tab[r0 + 128]; s1[i] += tab[r1 + 128];
                    if ((i & 3) == 3) __builtin_amdgcn_sched_barrier(0);
                }
            }
            if (lastmask) {
#pragma unroll
                for (int i = 0; i < 16; ++i) {
                    const int key = 64 * j + (i & 3) + 8 * (i >> 2) + 4 * hf;
                    if (key >= U.nkeys) s0[i] = -1e30f;
                    if (key + 32 >= U.nkeys) s1[i] = -1e30f;
                }
            }
            float rs = 0.f;
#pragma unroll
            for (int i = 0; i < 16; ++i) {
                s0[i] = __builtin_amdgcn_exp2f(__builtin_fmaf(s0[i], LOG2E, -mL));
                s1[i] = __builtin_amdgcn_exp2f(__builtin_fmaf(s1[i], LOG2E, -mL));
                rs += s0[i] + s1[i];
            }
            lrow += rs;
#pragma unroll
            for (int s = 0; s < 2; ++s) {
                u32x4 a, b;
                a.x = pk2(s0[8 * s + 0], s0[8 * s + 1]); a.y = pk2(s0[8 * s + 2], s0[8 * s + 3]); a.z = pk2(s0[8 * s + 4], s0[8 * s + 5]); a.w = pk2(s0[8 * s + 6], s0[8 * s + 7]);
                b.x = pk2(s1[8 * s + 0], s1[8 * s + 1]); b.y = pk2(s1[8 * s + 2], s1[8 * s + 3]); b.z = pk2(s1[8 * s + 4], s1[8 * s + 5]); b.w = pk2(s1[8 * s + 6], s1[8 * s + 7]);
                pf[0][s] = __builtin_bit_cast(bf16x8, a); pf[1][s] = __builtin_bit_cast(bf16x8, b);
            }
        }
        A_STOREK2(buf ^ 1, kq0, kq1);
        if (doit) {
#define A_VFRAG2(dst, h_) do { const unsigned char* vrow_ = Vb + ((h_) >> 1) * 32 * VROW_B; \
                _Pragma("unroll") for (int q_ = 0; q_ < 2; ++q_) { const int kb_ = (h_) & 1, s_ = q_; \
                    const u32x2 lo_ = *(const u32x2*)(vrow_ + (kb_ * 32 + 16 * s_) * 2); const u32x2 hi_ = *(const u32x2*)(vrow_ + (kb_ * 32 + 16 * s_ + 8) * 2); \
                    u32x4 vv_; vv_.x = lo_.x; vv_.y = lo_.y; vv_.z = hi_.x; vv_.w = hi_.y; dst[q_] = __builtin_bit_cast(bf16x8, vv_); } } while (0)
            const unsigned char* Vb = lds + ov_ + buf * 128 * VROW_B;
            bf16x8 va[2], vb[2];
            A_VFRAG2(va, 0); A_VFRAG2(vb, 1);
            __builtin_amdgcn_sched_barrier(0);
#pragma unroll
            for (int hh = 0; hh < 8; ++hh) {
                const int nt = hh >> 1, kb = hh & 1;
                if (kb == 0) { O[nt] = MFMA32(va[0], pf[kb][0], O[nt]); O[nt] = MFMA32(va[1], pf[kb][1], O[nt]); }
                else         { O[nt] = MFMA32(vb[0], pf[kb][0], O[nt]); O[nt] = MFMA32(vb[1], pf[kb][1], O[nt]); }
                __builtin_amdgcn_sched_barrier(0);
                if (hh + 2 < 8) { if (kb == 0) A_VFRAG2(va, hh + 2); else A_VFRAG2(vb, hh + 2); }
                __builtin_amdgcn_sched_barrier(0);
            }
#undef A_VFRAG2
        }
        A_STOREV2(buf ^ 1, vq0, vq1);
        __syncthreads();
            }
        ++j; if (j >= ntiles) break;
        {
        const int buf = j & 1;
        const bool more = (j + 1 < ntiles);
        A_LOADK2(j + 2, kq0, kq1); A_LOADV2(j + 2, vq0, vq1);
        const bool doit = active && j <= jmax_w;
        bf16x8 pf[2][2];
        if (doit) {
            const unsigned char* Kb = lds + ok_ + buf * 64 * KROW_B;
            const bool near = (64 * j + 63 + 91 > qpos_w);
            const bool lastmask = (64 * j + 64 > U.nkeys);
            f32x16 s0, s1;
#pragma unroll
            for (int i = 0; i < 16; ++i) { s0[i] = 0.f; s1[i] = 0.f; }
#pragma unroll
            for (int ks = 0; ks < 4; ++ks) {
                const bf16x8 qf = *(const bf16x8*)(Qb0 + ks * 32);
                const bf16x8 k0 = *(const bf16x8*)(Kb + ks * 32);
                const bf16x8 k1 = *(const bf16x8*)(Kb + 32 * KROW_B + ks * 32);
                s0 = MFMA32(k0, qf, s0); s1 = MFMA32(k1, qf, s1);
            }
            if (near) {
                const int qp = qpos_w + l31;
#pragma unroll
                for (int i = 0; i < 16; ++i) {
                    const int key = 64 * j + (i & 3) + 8 * (i >> 2) + 4 * hf;
                    int r0 = key - qp, r1 = key + 32 - qp;
                    r0 = r0 < -128 ? -128 : r0; r1 = r1 < -128 ? -128 : r1;
                    s0[i] += tab[r0 + 128]; s1[i] += tab[r1 + 128];
                    if ((i & 3) == 3) __builtin_amdgcn_sched_barrier(0);
                }
            }
            if (lastmask) {
#pragma unroll
                for (int i = 0; i < 16; ++i) {
                    const int key = 64 * j + (i & 3) + 8 * (i >> 2) + 4 * hf;
                    if (key >= U.nkeys) s0[i] = -1e30f;
                    if (key + 32 >= U.nkeys) s1[i] = -1e30f;
                }
            }
            float rs = 0.f;
#pragma unroll
            for (int i = 0; i < 16; ++i) {
                s0[i] = __builtin_amdgcn_exp2f(__builtin_fmaf(s0[i], LOG2E, -mL));
                s1[i] = __builtin_amdgcn_exp2f(__builtin_fmaf(s1[i], LOG2E, -mL));
                rs += s0[i] + s1[i];
            }
            lrow += rs;
#pragma unroll
            for (int s = 0; s < 2; ++s) {
                u32x4 a, b;
                a.x = pk2(s0[8 * s + 0], s0[8 * s + 1]); a.y = pk2(s0[8 * s + 2], s0[8 * s + 3]); a.z = pk2(s0[8 * s + 4], s0[8 * s + 5]); a.w = pk2(s0[8 * s + 6], s0[8 * s + 7]);
                b.x = pk2(s1[8 * s + 0], s1[8 * s + 1]); b.y = pk2(s1[8 * s + 2], s1[8 * s + 3]); b.z = pk2(s1[8 * s + 4], s1[8 * s + 5]); b.w = pk2(s1[8 * s + 6], s1[8 * s + 7]);
                pf[0][s] = __builtin_bit_cast(bf16x8, a); pf[1][s] = __builtin_bit_cast(bf16x8, b);
            }
        }
        A_STOREK2(buf ^ 1, kr0, kr1);
        if (doit) {
#define A_VFRAG2(dst, h_) do { const unsigned char* vrow_ = Vb + ((h_) >> 1) * 32 * VROW_B; \
                _Pragma("unroll") for (int q_ = 0; q_ < 2; ++q_) { const int kb_ = (h_) & 1, s_ = q_; \
                    const u32x2 lo_ = *(const u32x2*)(vrow_ + (kb_ * 32 + 16 * s_) * 2); const u32x2 hi_ = *(const u32x2*)(vrow_ + (kb_ * 32 + 16 * s_ + 8) * 2); \
                    u32x4 vv_; vv_.x = lo_.x; vv_.y = lo_.y; vv_.z = hi_.x; vv_.w = hi_.y; dst[q_] = __builtin_bit_cast(bf16x8, vv_); } } while (0)
            const unsigned char* Vb = lds + ov_ + buf * 128 * VROW_B;
            bf16x8 va[2], vb[2];
            A_VFRAG2(va, 0); A_VFRAG2(vb, 1);
            __builtin_amdgcn_sched_barrier(0);
#pragma unroll
            for (int hh = 0; hh < 8; ++hh) {
                const int nt = hh >> 1, kb = hh & 1;
                if (kb == 0) { O[nt] = MFMA32(va[0], pf[kb][0], O[nt]); O[nt] = MFMA32(va[1], pf[kb][1], O[nt]); }
                else         { O[nt] = MFMA32(vb[0], pf[kb][0], O[nt]); O[nt] = MFMA32(vb[1], pf[kb][1], O[nt]); }
                __builtin_amdgcn_sched_barrier(0);
                if (hh + 2 < 8) { if (kb == 0) A_VFRAG2(va, hh + 2); else A_VFRAG2(vb, hh + 2); }
                __builtin_amdgcn_sched_barrier(0);
            }
#undef A_VFRAG2
        }
        A_STOREV2(buf ^ 1, vr0, vr1);
        __syncthreads();
            }
    }
#undef A_LOADK2
#undef A_LOADV2
#undef A_STOREK2
#undef A_STOREV2
    const float ltot = lrow + __shfl_xor(lrow, 32);
    const float sc = (c == 0 ? 1.0f : lam) / ltot;
    unsigned char* exrow = lds + A_EX + (32 * wq + l31) * EXROW_B;
    if (active && c == 1) {
#pragma unroll
        for (int nt = 0; nt < 4; ++nt)
#pragma unroll
            for (int a = 0; a < 4; ++a) {
                f32x4 v = {O[nt][4 * a] * sc, O[nt][4 * a + 1] * sc, O[nt][4 * a + 2] * sc, O[nt][4 * a + 3] * sc};
                *(f32x4*)(exrow + (nt * 32 + 8 * a + 4 * hf) * 4) = v;
            }
    }
    __syncthreads();
    if (active && c == 0) {
        float ss = 0.f;
#pragma unroll
        for (int nt = 0; nt < 4; ++nt)
#pragma unroll
            for (int a = 0; a < 4; ++a) {
                const f32x4 v = *(const f32x4*)(exrow + (nt * 32 + 8 * a + 4 * hf) * 4);
#pragma unroll
                for (int e = 0; e < 4; ++e) { const float o = O[nt][4 * a + e] * sc - v[e]; O[nt][4 * a + e] = o; ss += o * o; }
            }
        ss += __shfl_xor(ss, 32);
        const float rs = rsqrtf(ss * (1.0f / 128.0f) + EPS) * 0.8f;
        bf16_t* orow = OA + (size_t)(U.qrow0 + 32 * wq + l31) * 1024 + h * 128;
#pragma unroll
        for (int nt = 0; nt < 4; ++nt)
#pragma unroll
            for (int a = 0; a < 4; ++a) {
                const int dv = nt * 32 + 8 * a + 4 * hf;
                const f32x4 g = *(const f32x4*)(subln_g + dv);
                u32x2 wv; wv.x = pk2(O[nt][4 * a + 0] * rs * g[0], O[nt][4 * a + 1] * rs * g[1]); wv.y = pk2(O[nt][4 * a + 2] * rs * g[2], O[nt][4 * a + 3] * rs * g[3]);
                *(u32x2*)(orow + dv) = wv;
            }
    }
    __syncthreads();
}

DI void attn_a_phase(const Params& P, unsigned char* lds, int G, int c) {
    unsigned char* ws = P.ws;
    const bf16_t* QA = (const bf16_t*)(ws + WS_QA); const bf16_t* KA = (const bf16_t*)(ws + WS_KA); const bf16_t* VA = (const bf16_t*)(ws + WS_VA);
    bf16_t* OA = (bf16_t*)(ws + WS_H);
    float lam;
    {
        const int lane = threadIdx.x & 63;
        const float a = wave_sum(P.in[12][lane] * P.in[13][lane]), b = wave_sum(P.in[14][lane] * P.in[15][lane]);
        lam = __expf(a) - __expf(b) + 0.2f;
    }
    float mbound;
    {
        const int lane = threadIdx.x & 63;
        float gq = fmaxf(fabsf(P.in[10][lane]), fabsf(P.in[10][lane + 64])), gk = fmaxf(fabsf(P.in[11][lane]), fabsf(P.in[11][lane + 64]));
        float bm = 0.f;
        for (int i = lane; i < 32 * 8; i += 64) { const int b = i >> 3, h = i & 7; bm = fmaxf(bm, fabsf(P.in[7][b * 16 + h] - P.in[7][15 * 16 + h])); }
#pragma unroll
        for (int o = 1; o < 64; o <<= 1) { gq = fmaxf(gq, __shfl_xor(gq, o)); gk = fmaxf(gk, __shfl_xor(gk, o)); bm = fmaxf(bm, __shfl_xor(bm, o)); }
        mbound = 8.0f * gq * gk + bm;
    }
    for (int k = c; k < 512; k += G) {
#pragma unroll 1
        for (int half = 0; half < 2; ++half) {
            const int h = k & 7, ii = k >> 3;
            const int i = half ? 127 - ii : ii;
            AttnUnit u{h, 128 * i, 128, 128 * i, 0, TP};
            attn_a_unit(u, QA, KA, VA, OA, P.in[7], P.in[16], lam, mbound, lds);
        }
    }
    for (int su = c; su < NB * 8; su += G) {
        const int h = su & 7, b = su >> 3;
        AttnUnit u{h, TP + 32 * b, 32, PAST, TP + b * NKS, NKS};
        attn_a_unit(u, QA, KA, VA, OA, P.in[7], P.in[16], lam, mbound, lds);
    }
}

constexpr int D_TABB = 0;
constexpr int D_CNT = D_TABB + 8 * 192 * 4;
constexpr int D_WTOT = D_CNT + 2 * 8 * 2 * 4;
constexpr int D_SEL = D_WTOT + 8 * 2 * 4 + 64;
constexpr int D_KST = D_SEL + 4 * 256 * 4;
constexpr int KST_BYTES = 256 * 128;
constexpr int DCAP = 2048;
constexpr int D_CU = D_KST;
constexpr int D_CK = D_CU + 2 * DCAP * 4;
constexpr int D_PN = D_KST + KST_BYTES;
constexpr int D_END = D_KST + 4 * KST_BYTES;
static_assert(D_END <= LDS_BYTES && D_CK + 2 * DCAP * 2 <= D_END, "dsa LDS");

DI void lds_barrier() { asm volatile("s_waitcnt lgkmcnt(0)" ::: "memory"); __builtin_amdgcn_s_barrier(); asm volatile("" ::: "memory"); }
DI unsigned f2sort(float f) { const unsigned u = __float_as_uint(f); return (u & 0x80000000u) ? ~u : (u | 0x80000000u); }
#define NEGKEY 0x007fffffu

DI void dsa_select(int tok0, int kbase, int L, int slot, const bf16_t* __restrict__ QI, const bf16_t* __restrict__ KI, const float* __restrict__ WI, unsigned char* lds) {
    int tid = threadIdx.x; asm volatile("" : "+v"(tid)); int lane = tid & 63;
    const int w = __builtin_amdgcn_readfirstlane(tid >> 6), hf = lane >> 5, l31 = lane & 31;
    const int NT = L >> 5;
    int* cntx = (int*)(lds + D_CNT); int* wtot = (int*)(lds + D_WTOT); int* sel = (int*)(lds + D_SEL);
    unsigned u[64];
    {
        const int r = l31, rq = (r >> 2) & 1, rh = (r >> 3) * 4 + (r & 3);
        bf16x8 qf[4];
#pragma unroll
        for (int ks = 0; ks < 4; ++ks) qf[ks] = *(const bf16x8*)(QI + (size_t)(tok0 + rq) * 1024 + rh * 64 + ks * 16 + hf * 8);
        float wv[16];
#pragma unroll
        for (int i = 0; i < 4; ++i) { const f32x4 t = *(const f32x4*)(WI + (size_t)(tok0 + hf) * 16 + 4 * i); wv[4 * i] = t[0]; wv[4 * i + 1] = t[1]; wv[4 * i + 2] = t[2]; wv[4 * i + 3] = t[3]; }
        int nstage = (NT + 7) >> 3;
        const int krow_ = lane >> 3, x0_ = (lane & 7) ^ (lane >> 4), x1_ = (lane & 7) ^ (4 + (lane >> 4));
        const char* gsrc = (const char*)(KI + (size_t)kbase * 64) + (size_t)(w * 32 + krow_) * 128;
        const int go0 = x0_ * 16, go1 = 8 * 128 + x1_ * 16, go2 = 16 * 128 + x0_ * 16, go3 = 24 * 128 + x1_ * 16;
        PG8_LAS unsigned char* lds3 = (PG8_LAS unsigned char*)lds;
        const int ldst = D_KST + w * 4096;
        const int xr_ = (l31 >> 1) & 7;
        const unsigned char* lrd = lds + D_KST + (w * 32 + l31) * 128;
        const int ro0 = ((0 + hf) ^ xr_) * 16, ro1 = ((2 + hf) ^ xr_) * 16, ro2 = ((4 + hf) ^ xr_) * 16, ro3 = ((6 + hf) ^ xr_) * 16;
#define D_DMA(bi) do { asm volatile("" : "+v"(gsrc)); \
        __builtin_amdgcn_global_load_lds((const unsigned*)(gsrc + go0), (PG8_LAS unsigned*)(lds3 + ldst + (bi) * KST_BYTES), 16, 0, 0); \
        __builtin_amdgcn_global_load_lds((const unsigned*)(gsrc + go1), (PG8_LAS unsigned*)(lds3 + ldst + (bi) * KST_BYTES + 1024), 16, 0, 0); \
        __builtin_amdgcn_global_load_lds((const unsigned*)(gsrc + go2), (PG8_LAS unsigned*)(lds3 + ldst + (bi) * KST_BYTES + 2048), 16, 0, 0); \
        __builtin_amdgcn_global_load_lds((const unsigned*)(gsrc + go3), (PG8_LAS unsigned*)(lds3 + ldst + (bi) * KST_BYTES + 3072), 16, 0, 0); \
        gsrc += KST_BYTES; } while (0)
        D_DMA(0); D_DMA(1);
        asm volatile("s_waitcnt vmcnt(0)" ::: "memory"); __builtin_amdgcn_s_barrier(); asm volatile("" ::: "memory");
#pragma unroll
        for (int g = 0; g < 8; ++g) {
            asm volatile("" : "+s"(nstage));
            if (nstage > 8 * g) {
#pragma unroll
                for (int e = 0; e < 4; ++e) {
                    const int sa = g * 8 + 2 * e, sb = sa + 1;
                    const int boa = (sa & 3) * KST_BYTES, bob = (sb & 3) * KST_BYTES;
                    D_DMA((sa + 2) & 3); D_DMA((sb + 2) & 3);
                    f32x16 da, db;
#pragma unroll
                    for (int i = 0; i < 16; ++i) { da[i] = 0.f; db[i] = 0.f; }
                    { const bf16x8 a0 = *(const bf16x8*)(lrd + boa + ro0), a1 = *(const bf16x8*)(lrd + boa + ro1), a2 = *(const bf16x8*)(lrd + boa + ro2), a3 = *(const bf16x8*)(lrd + boa + ro3);
                      const bf16x8 b0 = *(const bf16x8*)(lrd + bob + ro0), b1 = *(const bf16x8*)(lrd + bob + ro1), b2 = *(const bf16x8*)(lrd + bob + ro2), b3 = *(const bf16x8*)(lrd + bob + ro3);
                      da = MFMA32(qf[0], a0, da); db = MFMA32(qf[0], b0, db); da = MFMA32(qf[1], a1, da); db = MFMA32(qf[1], b1, db);
                      da = MFMA32(qf[2], a2, da); db = MFMA32(qf[2], b2, db); da = MFMA32(qf[3], a3, da); db = MFMA32(qf[3], b3, db); }
                    float sa0 = 0.f, sa1 = 0.f, sb0 = 0.f, sb1 = 0.f;
#pragma unroll
                    for (int i = 0; i < 8; ++i) {
                        sa0 = __builtin_fmaf(wv[2 * i], __builtin_amdgcn_fmed3f(da[2 * i], 0.f, __builtin_inff()), sa0); sa1 = __builtin_fmaf(wv[2 * i + 1], __builtin_amdgcn_fmed3f(da[2 * i + 1], 0.f, __builtin_inff()), sa1);
                        sb0 = __builtin_fmaf(wv[2 * i], __builtin_amdgcn_fmed3f(db[2 * i], 0.f, __builtin_inff()), sb0); sb1 = __builtin_fmaf(wv[2 * i + 1], __builtin_amdgcn_fmed3f(db[2 * i + 1], 0.f, __builtin_inff()), sb1);
                    }
                    u[sa] = (sa * 8 + w < NT) ? f2sort(sa0 + sa1) : NEGKEY;
                    u[sb] = (sb * 8 + w < NT) ? f2sort(sb0 + sb1) : NEGKEY;
                    asm volatile("s_waitcnt vmcnt(0)\n\ts_waitcnt lgkmcnt(0)" ::: "memory"); __builtin_amdgcn_s_barrier(); asm volatile("" ::: "memory");
                }
            } else {
#pragma unroll
                for (int e = 0; e < 8; ++e) u[g * 8 + e] = NEGKEY;
            }
        }
#undef D_DMA
    }
    const int nsel = L < 256 ? L : 256;
    unsigned* candU = (unsigned*)(lds + D_CU); unsigned short* candK = (unsigned short*)(lds + D_CK);
    bool fast = false;
    unsigned LB = 0u; int cbase = 0, cexcl = 0, ctot0 = 0, ctot1 = 0;
    if (L > 256) {
        unsigned m1 = u[0], m2 = 0u;
#pragma unroll
        for (int i = 1; i < 64; ++i) { const unsigned lo_ = m1 < u[i] ? m1 : u[i]; m2 = m2 > lo_ ? m2 : lo_; m1 = m1 > u[i] ? m1 : u[i]; }
        const unsigned p1 = (unsigned)__shfl_xor((int)m1, 1), p2 = (unsigned)__shfl_xor((int)m2, 1);
        const unsigned mx = m1 > p1 ? m1 : p1;
        const unsigned lo1 = m1 < p1 ? m1 : p1, hi2 = m2 > p2 ? m2 : p2;
        unsigned mn = lo1 > hi2 ? lo1 : hi2;
#pragma unroll
        for (int o = 1; o < 32; o <<= 1) { const unsigned t = (unsigned)__shfl_xor((int)mn, o); mn = mn < t ? mn : t; }
        unsigned mxx = mx;
#pragma unroll
        for (int o = 1; o < 32; o <<= 1) { const unsigned t = (unsigned)__shfl_xor((int)mxx, o); mxx = mxx > t ? mxx : t; }
        if (l31 == 0) { cntx[w * 2 + hf] = (int)mn; cntx[16 + w * 2 + hf] = (int)mxx; }
        __syncthreads();
        LB = (unsigned)cntx[hf];
#pragma unroll
        for (int ww = 1; ww < 8; ++ww) { const unsigned t = (unsigned)cntx[ww * 2 + hf]; LB = LB < t ? LB : t; }
        int cc = 0;
#pragma unroll
        for (int i = 0; i < 64; ++i) cc += (u[i] >= LB) ? 1 : 0;
        int incl = cc;
#pragma unroll
        for (int o = 1; o < 32; o <<= 1) { const int t = __shfl_up(incl, o, 32); if (l31 >= o) incl += t; }
        if (l31 == 31) wtot[w * 2 + hf] = incl;
        __syncthreads();
#pragma unroll
        for (int ww = 0; ww < 8; ++ww) { const int t0 = wtot[ww * 2], t1 = wtot[ww * 2 + 1]; ctot0 += t0; ctot1 += t1; if (ww < w) cbase += hf ? t1 : t0; }
        cexcl = incl - cc;
        fast = (ctot0 <= DCAP) && (ctot1 <= DCAP);
    }
    if (fast) {
        {
            int pos = cbase + cexcl;
            asm volatile("" : "+v"(LB));
#pragma unroll
            for (int i = 0; i < 64; ++i) if (u[i] >= LB) { candU[hf * DCAP + pos] = u[i]; candK[hf * DCAP + pos] = (unsigned short)((i * 8 + w) * 32 + l31); ++pos; }
        }
        __syncthreads();
        const int qq = w >> 2, ts = tid & 255, ntot = qq ? ctot1 : ctot0;
        unsigned cu[8];
#pragma unroll
        for (int k = 0; k < 8; ++k) { const int idx = ts + 256 * k; cu[k] = idx < ntot ? candU[qq * DCAP + idx] : 0u; }
        unsigned* tq = (unsigned*)(lds + D_WTOT) + 16;
        if (w < 2) {
            const int nt_ = w ? ctot1 : ctot0;
            unsigned lbq = (unsigned)cntx[w], mxq = (unsigned)cntx[16 + w];
#pragma unroll
            for (int ww = 1; ww < 8; ++ww) { const unsigned a_ = (unsigned)cntx[ww * 2 + w], b_ = (unsigned)cntx[16 + ww * 2 + w]; lbq = lbq < a_ ? lbq : a_; mxq = mxq > b_ ? mxq : b_; }
            lbq = __builtin_amdgcn_readfirstlane(lbq); mxq = __builtin_amdgcn_readfirstlane(mxq);
            unsigned ce[32];
#pragma unroll
            for (int k = 0; k < 32; ++k) { const int idx = lane + 64 * k; ce[k] = idx < nt_ ? (candU[w * DCAP + idx] - lbq) : 0u; }
            const unsigned span = mxq - lbq;
            const int nb = span ? 32 - __builtin_clz(span) : 0;
            unsigned Tw = 0u;
            int kmax = (nt_ + 63) >> 6;
            for (int bit = nb - 1; bit >= 0; --bit) {
                const unsigned cand = Tw | (1u << bit);
                int cl = 0;
#pragma unroll
                for (int g = 0; g < 4; ++g) {
                    if (kmax > 8 * g) {
#pragma unroll
                        for (int e = 0; e < 8; ++e) cl += (ce[g * 8 + e] >= cand) ? 1 : 0;
                    }
                }
                int n = 0;
#pragma unroll
                for (int b_ = 0; b_ < 6; ++b_) n += __builtin_popcountll(__builtin_amdgcn_ballot_w64(((cl >> b_) & 1) != 0)) << b_;
                if (n == 256) { Tw = cand - 1u; break; }
                if (n > 256) Tw = cand;
            }
            Tw += lbq;
            if (lane == 0) tq[w] = Tw;
        }
        __syncthreads();
        unsigned T = tq[qq];
        int c2 = 0;
#pragma unroll
        for (int k = 0; k < 8; ++k) c2 += (cu[k] > T ? 1 : 0) + (cu[k] == T ? 65536 : 0);
        int incl = c2;
#pragma unroll
        for (int o = 1; o < 64; o <<= 1) { const int t = __shfl_up(incl, o, 64); if (lane >= o) incl += t; }
        if (lane == 63) wtot[w] = incl;
        __syncthreads();
        int base = 0, total = 0;
#pragma unroll
        for (int ww = 0; ww < 4; ++ww) { const int t = wtot[qq * 4 + ww]; total += t; if (ww < (w & 3)) base += t; }
        const int excl = incl - c2;
        int pos_gt = (base & 0xffff) + (excl & 0xffff);
        int pos_eq = (total & 0xffff) + (base >> 16) + (excl >> 16);
        int* sl = sel + (slot + qq) * 256;
        asm volatile("" : "+v"(T));
#pragma unroll
        for (int k = 0; k < 8; ++k) {
            const int idx = ts + 256 * k;
            if (cu[k] > T) { if (pos_gt < 256) sl[pos_gt] = candK[qq * DCAP + idx]; ++pos_gt; }
            else if (cu[k] == T) { if (pos_eq < 256) sl[pos_eq] = candK[qq * DCAP + idx]; ++pos_eq; }
        }
        __syncthreads();
    } else {
        unsigned T = NEGKEY;
        if (L > 256) {
            unsigned T0 = 0u, T1 = 0u;
            int par = 0;
            for (int bit = 31; bit >= 0; --bit) {
                const unsigned c0 = T0 | (1u << bit), c1 = T1 | (1u << bit);
                const unsigned cand = hf ? c1 : c0;
                int cn = 0;
#pragma unroll
                for (int i = 0; i < 64; ++i) cn += (u[i] >= cand) ? 1 : 0;
                cn += __shfl_xor(cn, 1); cn += __shfl_xor(cn, 2); cn += __shfl_xor(cn, 4); cn += __shfl_xor(cn, 8); cn += __shfl_xor(cn, 16);
                if (l31 == 0) cntx[par * 16 + w * 2 + hf] = cn;
                __syncthreads();
                int t0 = 0, t1 = 0;
#pragma unroll
                for (int ww = 0; ww < 8; ++ww) { t0 += cntx[par * 16 + ww * 2]; t1 += cntx[par * 16 + ww * 2 + 1]; }
                if (t0 >= 256) T0 = c0;
                if (t1 >= 256) T1 = c1;
                par ^= 1;
            }
            T = hf ? T1 : T0;
        }
        asm volatile("" : "+v"(T));
        int c2 = 0;
#pragma unroll
        for (int ii = 0; ii < 64; ++ii) c2 += (u[ii] > T ? 1 : 0) + (u[ii] == T ? 65536 : 0);
        int incl = c2;
#pragma unroll
        for (int o = 1; o < 32; o <<= 1) { const int t = __shfl_up(incl, o, 32); if (l31 >= o) incl += t; }
        if (l31 == 31) wtot[w * 2 + hf] = incl;
        __syncthreads();
        int base = 0, total = 0;
#pragma unroll
        for (int ww = 0; ww < 8; ++ww) { const int t = wtot[ww * 2 + hf]; total += t; if (ww < w) base += t; }
        const int excl = incl - c2;
        const int total_gt = total & 0xffff;
        int pos_gt = (base & 0xffff) + (excl & 0xffff);
        int pos_eq = total_gt + (base >> 16) + (excl >> 16);
        int* sl = sel + (slot + hf) * 256;
        asm volatile("" : "+v"(T));
#pragma unroll
        for (int ii = 0; ii < 64; ++ii) {
            const int key = (ii * 8 + w) * 32 + l31;
            if (u[ii] > T) { if (pos_gt < 256) sl[pos_gt] = key; ++pos_gt; }
            else if (u[ii] == T) { if (pos_eq < nsel) sl[pos_eq] = key; ++pos_eq; }
        }
        __syncthreads();
    }
}

DI void dsa_sparse(int tok, int qpos, int kbase, int nsel, int n, const int* sl, float* pw, const float* tabB,
                   const bf16_t* __restrict__ QB, const bf16_t* __restrict__ KB, const bf16_t* __restrict__ VB, bf16_t* __restrict__ OB) {
    int lane = threadIdx.x & 63; asm volatile("" : "+v"(lane));
    {
        const int row = lane & 15, kg = lane >> 4;
        bf16x8 qf[4];
#pragma unroll
        for (int ks = 0; ks < 4; ++ks) {
            u32x4 z = {0u, 0u, 0u, 0u};
            if (row < 4) z = *(const u32x4*)(QB + (size_t)tok * 1024 + (n * 4 + row) * 128 + ks * 32 + kg * 8);
            qf[ks] = __builtin_bit_cast(bf16x8, z);
        }
#pragma unroll 1
        for (int tb = 0; tb < 4; ++tb) {
            bf16x8 kf[4][4]; int keyv[4];
#pragma unroll
            for (int e = 0; e < 4; ++e) {
                const int j = (tb * 4 + e) * 16 + row;
                const int jj = j < nsel ? j : nsel - 1;
                keyv[e] = sl[jj];
                const bf16_t* kp = KB + (size_t)(kbase + keyv[e]) * 256 + n * 128 + kg * 8;
#pragma unroll
                for (int ks = 0; ks < 4; ++ks) kf[e][ks] = *(const bf16x8*)(kp + ks * 32);
            }
#pragma unroll
            for (int e = 0; e < 4; ++e) {
                const int j = (tb * 4 + e) * 16 + row;
                f32x4 d = {0.f, 0.f, 0.f, 0.f};
#pragma unroll
                for (int ks = 0; ks < 4; ++ks) d = MFMA16(qf[ks], kf[e][ks], d);
                int rel = keyv[e] - qpos; rel = rel < -128 ? -128 : rel;
                f32x4 v;
#pragma unroll
                for (int g = 0; g < 4; ++g) { const float x = d[g] * 0.08838834764831845f + tabB[(n * 4 + g) * 192 + rel + 128]; v[g] = (j < nsel) ? x : -1e30f; }
                if (kg == 0) *(f32x4*)(pw + j * 4) = v;
            }
        }
    }
    {
        f32x4 v[4];
#pragma unroll
        for (int e = 0; e < 4; ++e) v[e] = *(const f32x4*)(pw + (e * 64 + lane) * 4);
#pragma unroll
        for (int g = 0; g < 4; ++g) {
            float m = fmaxf(fmaxf(v[0][g], v[1][g]), fmaxf(v[2][g], v[3][g]));
#pragma unroll
            for (int o = 1; o < 64; o <<= 1) m = fmaxf(m, __shfl_xor(m, o));
            float sum = 0.f;
#pragma unroll
            for (int e = 0; e < 4; ++e) { v[e][g] = __expf(v[e][g] - m); sum += v[e][g]; }
            sum = wave_sum(sum);
            const float inv = 1.0f / sum;
#pragma unroll
            for (int e = 0; e < 4; ++e) v[e][g] *= inv;
        }
        asm volatile("" ::: "memory");
        {
            unsigned* pbs = (unsigned*)pw;
#pragma unroll
            for (int e = 0; e < 4; ++e) {
                const int j = e * 64 + lane;
#pragma unroll
                for (int g = 0; g < 4; ++g) {
                    const unsigned own = pk2(v[e][g], 0.f) & 0xffffu;
                    const unsigned oth = (unsigned)__shfl_xor((int)own, 1);
                    if ((lane & 1) == 0) pbs[(j >> 1) * 4 + g] = own | (oth << 16);
                }
            }
        }
    }
    {
        const int ksub = lane >> 4, dc = lane & 15;
        float acc[4][8];
#pragma unroll
        for (int g = 0; g < 4; ++g)
#pragma unroll
            for (int e = 0; e < 8; ++e) acc[g][e] = 0.f;
        const bf16_t* vbase = VB + (size_t)kbase * 256 + n * 128 + dc * 8;
        asm volatile("" ::: "memory");
        const unsigned* pbw = (const unsigned*)pw;
#pragma unroll 1
        for (int j0 = 0; j0 < nsel; j0 += 64) {
            u32x4 va[8], vb[8];
#pragma unroll
            for (int i = 0; i < 8; ++i) {
                const int j = j0 + i * 8 + ksub * 2;
                const int ja = j < nsel ? j : nsel - 1, jb = (j + 1) < nsel ? (j + 1) : nsel - 1;
                va[i] = *(const u32x4*)(vbase + (size_t)sl[ja] * 256);
                vb[i] = *(const u32x4*)(vbase + (size_t)sl[jb] * 256);
            }
#pragma unroll
            for (int i = 0; i < 8; ++i) {
                const int j = j0 + i * 8 + ksub * 2;
                u32x4 pp = *(const u32x4*)(pbw + (j >> 1) * 4);
                if (j >= nsel) pp = (u32x4){0u, 0u, 0u, 0u};
                unsigned wd[8];
                wd[0] = __builtin_amdgcn_perm(vb[i].x, va[i].x, 0x05040100u); wd[1] = __builtin_amdgcn_perm(vb[i].x, va[i].x, 0x07060302u);
                wd[2] = __builtin_amdgcn_perm(vb[i].y, va[i].y, 0x05040100u); wd[3] = __builtin_amdgcn_perm(vb[i].y, va[i].y, 0x07060302u);
                wd[4] = __builtin_amdgcn_perm(vb[i].z, va[i].z, 0x05040100u); wd[5] = __builtin_amdgcn_perm(vb[i].z, va[i].z, 0x07060302u);
                wd[6] = __builtin_amdgcn_perm(vb[i].w, va[i].w, 0x05040100u); wd[7] = __builtin_amdgcn_perm(vb[i].w, va[i].w, 0x07060302u);
#pragma unroll
                for (int g = 0; g < 4; ++g) {
                    const unsigned pgu = (g == 0) ? pp.x : (g == 1) ? pp.y : (g == 2) ? pp.z : pp.w;
                    const bf16x2_t pg = __builtin_bit_cast(bf16x2_t, pgu);
#pragma unroll
                    for (int e = 0; e < 8; ++e) acc[g][e] = __builtin_amdgcn_fdot2_f32_bf16(__builtin_bit_cast(bf16x2_t, wd[e]), pg, acc[g][e], false);
                }
            }
        }
#pragma unroll
        for (int g = 0; g < 4; ++g) {
#pragma unroll
            for (int e = 0; e < 8; ++e) { float a = acc[g][e]; a += __shfl_xor(a, 16); a += __shfl_xor(a, 32); acc[g][e] = a; }
            if (ksub == 0) {
                u32x4 wv4; wv4.x = pk2(acc[g][0], acc[g][1]); wv4.y = pk2(acc[g][2], acc[g][3]); wv4.z = pk2(acc[g][4], acc[g][5]); wv4.w = pk2(acc[g][6], acc[g][7]);
                *(u32x4*)(OB + (size_t)tok * 1024 + (n * 4 + g) * 128 + dc * 8) = wv4;
            }
        }
    }
}

DI void dsa_phase(const Params& P, unsigned char* lds, int G, int c) {
    unsigned char* ws = P.ws;
    const bf16_t* QI = (const bf16_t*)(ws + WS_QI); const bf16_t* KI = (const bf16_t*)(ws + WS_KI); const float* WI = (const float*)(ws + WS_WI);
    const bf16_t* QB = (const bf16_t*)(ws + WS_QB); const bf16_t* KB = (const bf16_t*)(ws + WS_KB); const bf16_t* VB = (const bf16_t*)(ws + WS_VB);
    bf16_t* OB = (bf16_t*)(ws + WS_H) + (size_t)TT * 1024;
    float* tabB = (float*)(lds + D_TABB);
    for (int i = threadIdx.x; i < 8 * 192; i += NTHREADS) { const int hd = i / 192, rel = i % 192 - 128; tabB[i] = P.in[7][t5_bucket(rel) * 16 + 8 + hd]; }
    __syncthreads();
    const int w = __builtin_amdgcn_readfirstlane(threadIdx.x >> 6);
    const int nprompt = TP / 4, nsample = TS / 4;
    const int nmine = (nprompt - c + G - 1) / G, ps0 = (c + G / 2) % G;
    for (int k = 0; k < nmine + ((ps0 < nsample) ? (nsample - ps0 + G - 1) / G : 0); ++k) {
        const int it = (k < nmine) ? (c + k * G) : (nprompt + ps0 + (k - nmine) * G);
        int tok0, qpos0, kbase, L;
        if (it < TP / 4) { tok0 = 4 * it; qpos0 = tok0; kbase = 0; L = 64 * ((qpos0 >> 6) + 1); }
        else { const int p = it - TP / 4, b = p >> 3, t0 = (p & 7) * 4; tok0 = TP + 32 * b + t0; qpos0 = PAST + t0; kbase = TP + b * NKS; L = NKS; }
#pragma unroll 1
        for (int pr = 0; pr < 2; ++pr) dsa_select(tok0 + 2 * (pr & 1), kbase, L, 2 * (pr & 1), QI, KI, WI, lds);
        const int nsel = L < 256 ? L : 256;
        const int q = w >> 1, n = w & 1;
        dsa_sparse(tok0 + q, qpos0 + q, kbase, nsel, n, (const int*)(lds + D_SEL) + q * 256, (float*)(lds + D_PN) + w * 1024, tabB, QB, KB, VB, OB);
        __syncthreads();
    }
}

__global__ void __launch_bounds__(NTHREADS, 2) mega_fwd(Params P) {
    extern __shared__ __attribute__((aligned(16))) unsigned char lds[];
    const int G = gridDim.x, c = blockIdx.x;
    const int lo = P.ph_lo, hi = P.ph_hi;
    unsigned char* ws = P.ws;
    PG8_LAS unsigned char* ring = (PG8_LAS unsigned char*)lds;
#define IN_(k) (lo <= (k) && (k) < hi)
#define SEAM_(k) do { if (IN_(k) && IN_((k) + 1)) { cg::this_grid().sync(); } } while (0)
    if (IN_(0)) { for (int rep = 0; rep < (REP_PH == 0 ? 2 : 1); ++rep) { p0_prep(P, lds, G, c); __syncthreads(); } }
    SEAM_(0);
#ifndef SKIP_GEMM
    if (IN_(1)) for (int rep = 0; rep < (REP_PH == 1 ? 2 : 1); ++rep) {
        pg8::Gemm g{(const bf16_t*)(ws + WS_H), (const bf16_t*)(ws + WS_WT_IN), TT, NIN, DM, DM}; pg8::StaticOrder S; S.init(TT, NIN, G, c);
        EpiInProj E{P.out, ws, P.in[10], P.in[11], P.in[17], P.in[18], (float*)(lds + XCH_OFF)};
        pg8::gemm_phase<EpiInProj, pg8::StaticOrder, true, true>(ring, g, S, E);
    }
#endif
    SEAM_(1);
    if (IN_(2)) {
#ifndef SKIP_ATTN
        for (int rep = 0; rep < REP_ATTN; ++rep) { attn_a_phase(P, lds, G, c); __syncthreads(); }
#endif
#ifndef SKIP_DSA
        for (int rep = 0; rep < REP_DSA; ++rep) { dsa_phase(P, lds, G, c); }
#endif
    }
    SEAM_(2);
#ifndef SKIP_GEMM
    if (IN_(3)) for (int rep = 0; rep < (REP_PH == 3 ? 2 : 1); ++rep) {
        pg8::StaticOrder S; S.init(TT, DM, G, c);
        {
            pg8::Gemm g{(const bf16_t*)(ws + WS_H), (const bf16_t*)(ws + WS_WT_OA), TT, DM, 1024, 1024};
            EpiMerge<0> E{(const bf16_t*)(P.out + O_Y), (bf16_t*)(ws + WS_MERGED)};
            pg8::gemm_phase<EpiMerge<0>, pg8::StaticOrder, true, true>(ring, g, S, E);
        }
        __syncthreads();
        {
            pg8::Gemm g{(const bf16_t*)(ws + WS_H) + (size_t)TT * 1024, (const bf16_t*)(ws + WS_WT_OB), TT, DM, 1024, 1024};
            EpiMerge<1> E{(const bf16_t*)(P.out + O_Y), (bf16_t*)(ws + WS_MERGED)};
            pg8::gemm_phase<EpiMerge<1>, pg8::StaticOrder, true, true>(ring, g, S, E);
        }
    }
#endif
    SEAM_(3);
#ifndef SKIP_GEMM
    if (IN_(4)) for (int rep = 0; rep < (REP_PH == 4 ? 2 : 1); ++rep) {
        pg8::Gemm g{(const bf16_t*)(ws + WS_MERGED), (const bf16_t*)(ws + WS_WT_OUT), TT, DM, DM, DM}; pg8::StaticOrder S; S.init(TT, DM, G, c);
        EpiOut E{P.in[0], P.in[1], P.out + O_Y};
        pg8::gemm_phase<EpiOut, pg8::StaticOrder, true, true>(ring, g, S, E);
    }
#endif
    SEAM_(4);
    if (IN_(5)) { rmsnorm_rows(P.out + O_Y, P.out + O_Y + (size_t)TP * DM, P.in[22], (bf16_t*)(ws + WS_H), G, c); }
    SEAM_(5);
#ifndef SKIP_GEMM
    if (IN_(6)) for (int rep = 0; rep < (REP_PH == 6 ? 2 : 1); ++rep) {
        pg8::Gemm g{(const bf16_t*)(ws + WS_H), (const bf16_t*)(ws + WS_WT_FF1), TT, DFF, DM, DM}; pg8::StaticOrder S; S.init(TT, DFF, G, c);
        EpiFF1 E{(bf16_t*)(ws + WS_U)};
        pg8::gemm_phase<EpiFF1, pg8::StaticOrder, true, true>(ring, g, S, E);
    }
#endif
    SEAM_(6);
#ifndef SKIP_GEMM
    if (IN_(7)) {
        pg8::StaticOrder S; S.init(TT, DM, G, c);
        const int nunits = (TT / 256) * (DM / 256), rounds = nunits / G, left = nunits - rounds * G;
        {
            pg8::Gemm g{(const bf16_t*)(ws + WS_U), (const bf16_t*)(ws + WS_WT_FF2), TT, DM, DFF, DFF};
            OrderRounds SR{S, rounds};
            EpiFF2 E{P.out + O_Y};
            pg8::gemm_phase<EpiFF2, OrderRounds, true, true>(ring, g, SR, E);
        }
        for (int mi = c; mi < left * 16; mi += G) {
            const int r = mi % left, sl = mi / left;
            __syncthreads();
            pg8::Gemm g{(const bf16_t*)(ws + WS_U) + sl * 512, (const bf16_t*)(ws + WS_WT_FF2) + sl * 512, TT, DM, 512, DFF};
            OrderOne SO{S, rounds * G + r};
            EpiFF2Part E{(float*)(ws + WS_H) + (size_t)mi * 65536};
            pg8::gemm_phase<EpiFF2Part, OrderOne, true, true>(ring, g, SO, E);
        }
    }
    SEAM_(7);
    if (IN_(8)) {
        pg8::StaticOrder S; S.init(TT, DM, G, c);
        const int nunits = (TT / 256) * (DM / 256), rounds = nunits / G, left = nunits - rounds * G;
        const float* part = (const float*)(ws + WS_H);
        for (int t = c * NTHREADS + (int)threadIdx.x; t < left * 16384; t += G * NTHREADS) {
            const int r = t >> 14, e4 = t & 16383, rl = e4 >> 6, cl = (e4 & 63) * 4;
            pg8::Unit u; S.at((long)(rounds * G + r), u);
            f32x4 a = {0.f, 0.f, 0.f, 0.f};
#pragma unroll
            for (int sl = 0; sl < 16; ++sl) a += *(const f32x4*)(part + (size_t)(sl * left + r) * 65536 + rl * 256 + cl);
            float* yo = P.out + O_Y + (size_t)(u.pm * 256 + rl) * DM + u.pn * 256 + cl;
            *(f32x4*)yo = *(const f32x4*)yo + a;
        }
    }
#endif
}

extern "C" void kernel_launch(void* const* d_in, const int* in_sizes, int n_in, void* d_out, int out_size, void* d_ws, size_t ws_size, hipStream_t stream) {
    static int grid = 0;
    if (grid == 0) {
        if (n_in != 25 || (size_t)out_size != O_END || ws_size < WS_END) {
            fprintf(stderr, "kernel_launch: unexpected problem: n_in %d out_size %d (want %zu) ws %zu (want %zu)\n", n_in, out_size, (size_t)O_END, ws_size, (size_t)WS_END);
            grid = -1; return;
        }
        int dev = 0, cus = 0, per_cu = 0;
        hipGetDevice(&dev);
        hipDeviceGetAttribute(&cus, hipDeviceAttributeMultiprocessorCount, dev);
        hipFuncSetAttribute((const void*)mega_fwd, hipFuncAttributeMaxDynamicSharedMemorySize, LDS_BYTES);
        hipOccupancyMaxActiveBlocksPerMultiprocessor(&per_cu, (const void*)mega_fwd, NTHREADS, LDS_BYTES);
        if (per_cu < 1) { fprintf(stderr, "kernel_launch: occupancy query says %d blocks per CU\n", per_cu); per_cu = 1; }
        (void)hipGetLastError();
        grid = cus * per_cu;
    }
    if (grid < 0) return;
    Params p{};
    for (int i = 0; i < 25; ++i) p.in[i] = (const float*)d_in[i];
    p.out = (float*)d_out; p.ws = (unsigned char*)d_ws;
#if N_LAUNCH_MODE == 1
    p.ph_lo = 0; p.ph_hi = 9;
    void* args[] = {&p};
    hipError_t e = hipLaunchCooperativeKernel((const void*)mega_fwd, dim3(grid), dim3(NTHREADS), args, LDS_BYTES, stream);
    if (e != hipSuccess) fprintf(stderr, "cooperative launch failed: %s (grid %d)\n", hipGetErrorString(e), grid);
#else
    for (int ph = 0; ph < 9; ++ph) {
        p.ph_lo = ph; p.ph_hi = ph + 1;
        hipLaunchKernelGGL(mega_fwd, dim3(grid), dim3(NTHREADS), LDS_BYTES, stream, p);
    }
#endif
}
```

```cpp
#include <hip/hip_runtime.h>
#include <hip/hip_cooperative_groups.h>
#include <cstdio>
#include <cstdint>
namespace cg = cooperative_groups;
#ifndef N_LAUNCH_MODE
#define N_LAUNCH_MODE 1
#endif
#ifndef REP_ATTN
#define REP_ATTN 1
#endif
#ifndef REP_DSA
#define REP_DSA 1
#endif
#ifndef REP_IDX
#define REP_IDX 1
#endif
#ifndef REP_BIS
#define REP_BIS 1
#endif
#ifndef REP_SPARSE
#define REP_SPARSE 1
#endif
#ifndef REP_PH
#define REP_PH -1
#endif
#ifndef FORCE_SLOW
#define FORCE_SLOW 0
#endif
#ifndef XSYNC
#define XSYNC 0
#endif
namespace pg8 {
#define PG8_LAS __attribute__((address_space(3)))
typedef unsigned short bf16_t;
typedef short bf16x8 __attribute__((ext_vector_type(8)));
typedef float f32x4 __attribute__((ext_vector_type(4)));
typedef unsigned u32x4 __attribute__((ext_vector_type(4)));
constexpr int BM = 256, BK = 64, HALF = 128, HTB = HALF * BK * 2  , STAGE_BYTES = 8 * HTB, NXCD = 8, WGM = 8;

__host__ __device__ __forceinline__ int lds_byte(int r, int c) { const int st = (r >> 4) * 2 + (c >> 5), rr = r & 15, cc = c & 31, ob = rr * 64 + cc * 2; return st * 1024 + (ob ^ (((ob >> 9) & 1) << 5)); }
__host__ __device__ __forceinline__ void stage_rc(int b, int& R, int& C) { const int st = b / 1024, sb = b % 1024, swz = sb ^ (((sb >> 9) & 1) << 5); R = (st >> 1) * 16 + swz / 64; C = (st & 1) * 32 + (swz % 64) / 2; }
__host__ __device__ __forceinline__ int perm32(int rho) { const int n = rho >> 4, i = rho & 15; return 8 * (i >> 2) + 4 * n + (i & 3); }

struct Unit { int pm, pn; };
struct Gemm { const bf16_t* A; const bf16_t* Bt; int M, N, K, ld; };

struct StaticOrder {
    int nM, nN, nwg, G, c;
    __host__ __device__ void init(int M, int N, int G_, int c_) { nM = M / BM; nN = N / BM; nwg = nM * nN; G = G_; c = c_; }
    __host__ __device__ __forceinline__ bool next(int i, Unit& u) const { return at((long)i * G + c, u); }
    __host__ __device__ __forceinline__ bool at(const long L, Unit& u) const {
        if (L >= nwg) return false;
        int wgid = (int)L; { const int q = nwg / NXCD, r = nwg % NXCD, xcd = wgid % NXCD, off = wgid / NXCD; wgid = (xcd < r ? xcd * (q + 1) : r * (q + 1) + (xcd - r) * q) + off; }
        const int nig = WGM * nN, gid = wgid / nig, fm = gid * WGM, gsz = (nM - fm) < WGM ? (nM - fm) : WGM;
        u.pm = fm + ((wgid % nig) % gsz); u.pn = (wgid % nig) / gsz; return true;
    }
    __device__ __forceinline__ void a_ready(const Unit&) const {}
    __device__ __forceinline__ void done(const Unit&) const {}
};


template <class Epi, class Sched, bool ALIGN_EPI = false, bool SP2 = false>
__device__ __forceinline__ void gemm_phase(PG8_LAS unsigned char* lds, const Gemm g, const Sched& S, const Epi& E) {
    const int tid = threadIdx.x, wid = __builtin_amdgcn_readfirstlane(tid >> 6), lane = tid & 63, wr = wid >> 2, wc = wid & 3, fr = lane & 15, fq = lane >> 4;
    const int K = g.K, nt = K / BK, LD = g.ld;
    unsigned voffA[2], voffB[2];
#pragma unroll
    for (int i = 0; i < 2; ++i) { int R, C; stage_rc(tid * 16 + i * 8192, R, C); const int Rb = Epi::PERM ? ((R & ~31) + perm32(R & 31)) : R;
        voffA[i] = (unsigned)(R * LD + C) * 2u; voffB[i] = (unsigned)(Rb * LD + C) * 2u; }
    const size_t kstep = (size_t)(BK * 2);
    const size_t hstep = (size_t)HALF * LD * 2;
    const size_t tstep = 2 * hstep;
    const unsigned ldsw = (unsigned)wid * 1024u;
    const int aoff = lds_byte(wr * 64 + fr, fq * 8), boff = lds_byte(wc * 32 + fr, fq * 8);
#define PG8_SA(b, h) (((b) * 2 + (h)) * HTB)
#define PG8_SB(b, h) ((4 + (b) * 2 + (h)) * HTB)
#define PG8_STAGE(bufoff, gbase, voff) do { _Pragma("unroll") for (int _i = 0; _i < 2; ++_i) \
        __builtin_amdgcn_global_load_lds((const unsigned*)((const char*)(gbase) + (voff)[_i]), (PG8_LAS unsigned*)(lds + (bufoff) + ldsw + _i * 8192), 16, 0, 0); } while (0)
#define PG8_LDA(dst, b, h) do { _Pragma("unroll") for (int m = 0; m < 4; ++m) _Pragma("unroll") for (int k = 0; k < 2; ++k) dst[m][k] = *(const PG8_LAS bf16x8*)(lds + PG8_SA(b, h) + aoff + m * 2048 + k * 1024); } while (0)
#define PG8_LDB(dst, b, h) do { _Pragma("unroll") for (int n = 0; n < 2; ++n) _Pragma("unroll") for (int k = 0; k < 2; ++k) dst[n][k] = *(const PG8_LAS bf16x8*)(lds + PG8_SB(b, h) + boff + n * 2048 + k * 1024); } while (0)
#define PG8_MMA(ai, bj, At, Bt) do { __builtin_amdgcn_s_setprio(1); _Pragma("unroll") for (int m = 0; m < 4; ++m) _Pragma("unroll") for (int n = 0; n < 2; ++n) _Pragma("unroll") for (int k = 0; k < 2; ++k) \
        acc[ai][bj][m][n] = __builtin_amdgcn_mfma_f32_16x16x32_bf16(Bt[n][k], At[m][k], acc[ai][bj][m][n], 0, 0, 0); __builtin_amdgcn_s_setprio(0); } while (0)
#define PG8_WAIT_V(n) asm volatile("s_waitcnt vmcnt(" #n ")" ::: "memory")
#define PG8_WAIT_L(n) asm volatile("s_waitcnt lgkmcnt(" #n ")" ::: "memory")
#define PG8_BAR __builtin_amdgcn_s_barrier()
#define PG8_SCHED __builtin_amdgcn_sched_barrier(0)
    Unit cur, nxt; int ui = 0;
    if (!S.next(0, cur)) return;
    f32x4 acc[2][2][4][2];
#pragma unroll
    for (int a = 0; a < 2; ++a)
#pragma unroll
        for (int b = 0; b < 2; ++b)
#pragma unroll
            for (int m = 0; m < 4; ++m)
#pragma unroll
                for (int n = 0; n < 2; ++n) acc[a][b][m][n] = (f32x4){0.f, 0.f, 0.f, 0.f};
    bf16x8 At[4][2], B0[2][2], B1[2][2];
    const char* cA = (const char*)g.A + (size_t)cur.pm * tstep; const char* cB = (const char*)g.Bt + (size_t)cur.pn * tstep;
    S.a_ready(cur);
    if constexpr (SP2) {
        PG8_STAGE(PG8_SB(0, 0), cB, voffB); PG8_STAGE(PG8_SB(0, 1), cB + hstep, voffB); PG8_STAGE(PG8_SA(0, 0), cA, voffA); PG8_STAGE(PG8_SA(0, 1), cA + hstep, voffA);
        if (wr == 1) PG8_BAR;
        PG8_WAIT_V(2); PG8_BAR;
        PG8_STAGE(PG8_SB(1, 0), cB + kstep, voffB); PG8_STAGE(PG8_SA(1, 0), cA + kstep, voffA); PG8_STAGE(PG8_SB(1, 1), cB + hstep + kstep, voffB);
        PG8_WAIT_V(6); PG8_BAR;
    } else {
        PG8_STAGE(PG8_SB(0, 0), cB, voffB); PG8_STAGE(PG8_SA(0, 0), cA, voffA); PG8_STAGE(PG8_SB(0, 1), cB + hstep, voffB); PG8_STAGE(PG8_SA(0, 1), cA + hstep, voffA);
        if (wr == 1) PG8_BAR;
        PG8_WAIT_V(4); PG8_BAR;
        PG8_STAGE(PG8_SB(1, 0), cB + kstep, voffB); PG8_STAGE(PG8_SA(1, 0), cA + kstep, voffA); PG8_STAGE(PG8_SB(1, 1), cB + hstep + kstep, voffB);
        PG8_WAIT_V(6); PG8_BAR;
    }
    for (;;) {
        const bool has_next = S.next(ui + 1, nxt);
        const char* nA = has_next ? (const char*)g.A + (size_t)nxt.pm * tstep : cA; const char* nB = has_next ? (const char*)g.Bt + (size_t)nxt.pn * tstep : cB;
        for (int t = 0; t < nt; t += 2) {
            const bool last = (t == nt - 2);
            const char* a1 = cA + (size_t)(t + 1) * kstep;
            const char* a2 = last ? nA : cA + (size_t)(t + 2) * kstep; const char* b2 = last ? nB : cB + (size_t)(t + 2) * kstep;
            const char* a3 = a2 + kstep; const char* b3 = b2 + kstep;
            if (last && has_next) S.a_ready(nxt);
            if constexpr (SP2) {
            PG8_LDB(B0, 0, 0); PG8_LDB(B1, 0, 1); PG8_SCHED; PG8_LDA(At, 0, 0); PG8_STAGE(PG8_SA(1, 1), a1 + hstep, voffA);
            PG8_WAIT_V(8); PG8_WAIT_L(0); PG8_BAR; PG8_MMA(0, 0, At, B0); PG8_MMA(0, 1, At, B1); PG8_BAR; PG8_SCHED;
            PG8_LDA(At, 0, 1); PG8_STAGE(PG8_SB(0, 0), b2, voffB); PG8_STAGE(PG8_SB(0, 1), b2 + hstep, voffB); PG8_STAGE(PG8_SA(0, 0), a2, voffA);
            PG8_WAIT_V(8); PG8_WAIT_L(0); PG8_BAR; PG8_MMA(1, 0, At, B0); PG8_MMA(1, 1, At, B1); PG8_BAR; PG8_SCHED;
            PG8_LDB(B0, 1, 0); PG8_LDB(B1, 1, 1); PG8_SCHED; PG8_LDA(At, 1, 0); PG8_STAGE(PG8_SA(0, 1), a2 + hstep, voffA);
            PG8_WAIT_V(8); PG8_WAIT_L(0); PG8_BAR; PG8_MMA(0, 0, At, B0); PG8_MMA(0, 1, At, B1); PG8_BAR; PG8_SCHED;
            PG8_LDA(At, 1, 1); PG8_STAGE(PG8_SB(1, 0), b3, voffB); PG8_STAGE(PG8_SB(1, 1), b3 + hstep, voffB); PG8_STAGE(PG8_SA(1, 0), a3, voffA);
            PG8_WAIT_V(8); PG8_WAIT_L(0); PG8_BAR; PG8_MMA(1, 0, At, B0); PG8_MMA(1, 1, At, B1); PG8_BAR; PG8_SCHED;
            } else {
            PG8_LDB(B0, 0, 0); PG8_SCHED; PG8_LDA(At, 0, 0); PG8_STAGE(PG8_SA(1, 1), a1 + hstep, voffA);
            PG8_WAIT_L(8); PG8_BAR; PG8_WAIT_L(0); PG8_MMA(0, 0, At, B0); PG8_BAR; PG8_SCHED;
            PG8_LDB(B1, 0, 1); PG8_STAGE(PG8_SB(0, 0), b2, voffB);
            PG8_BAR; PG8_WAIT_L(0); PG8_MMA(0, 1, At, B1); PG8_BAR;
            PG8_LDA(At, 0, 1); PG8_STAGE(PG8_SA(0, 0), a2, voffA);
            PG8_BAR; PG8_WAIT_L(0); PG8_MMA(1, 0, At, B0); PG8_BAR; PG8_SCHED;
            PG8_STAGE(PG8_SB(0, 1), b2 + hstep, voffB);
            PG8_WAIT_V(6); PG8_BAR; PG8_MMA(1, 1, At, B1); PG8_BAR;
            PG8_LDB(B0, 1, 0); PG8_SCHED; PG8_LDA(At, 1, 0); PG8_STAGE(PG8_SA(0, 1), a2 + hstep, voffA);
            PG8_WAIT_L(8); PG8_BAR; PG8_WAIT_L(0); PG8_MMA(0, 0, At, B0); PG8_BAR; PG8_SCHED;
            PG8_LDB(B1, 1, 1); PG8_STAGE(PG8_SB(1, 0), b3, voffB);
            PG8_BAR; PG8_WAIT_L(0); PG8_MMA(0, 1, At, B1); PG8_BAR;
            PG8_LDA(At, 1, 1); PG8_STAGE(PG8_SA(1, 0), a3, voffA);
            PG8_BAR; PG8_WAIT_L(0); PG8_MMA(1, 0, At, B0); PG8_BAR; PG8_SCHED;
            PG8_STAGE(PG8_SB(1, 1), b3 + hstep, voffB);
            PG8_WAIT_V(6); PG8_BAR; PG8_MMA(1, 1, At, B1); PG8_BAR;
            }
        }
        if constexpr (ALIGN_EPI) { if (wr == 0) PG8_BAR; }
        if constexpr (!Epi::AFTER_DRAIN) { E(acc, cur, wr, wc, fr, fq); S.done(cur); }
        if (!has_next) break;
#pragma unroll
        for (int a = 0; a < 2; ++a)
#pragma unroll
            for (int b = 0; b < 2; ++b)
#pragma unroll
                for (int m = 0; m < 4; ++m)
#pragma unroll
                    for (int n = 0; n < 2; ++n) acc[a][b][m][n] = (f32x4){0.f, 0.f, 0.f, 0.f};
        cur = nxt; cA = nA; cB = nB; ++ui;
        if constexpr (ALIGN_EPI) { if (wr == 1) PG8_BAR; }
    }
    PG8_WAIT_V(0);
    if constexpr (!ALIGN_EPI) { if (wr == 0) PG8_BAR; }
    PG8_BAR;
    if constexpr (Epi::AFTER_DRAIN) { E.fused(acc, cur, wr, wc, fr, fq, lds, wid, lane); S.done(cur); }
#undef PG8_SA
#undef PG8_SB
#undef PG8_STAGE
#undef PG8_LDA
#undef PG8_LDB
#undef PG8_MMA
#undef PG8_WAIT_V
#undef PG8_WAIT_L
#undef PG8_BAR
#undef PG8_SCHED
}
}


#define DI __device__ __forceinline__
typedef unsigned short bf16_t;
typedef short bf16x8 __attribute__((ext_vector_type(8)));
typedef float f32x4 __attribute__((ext_vector_type(4)));
typedef float f32x16 __attribute__((ext_vector_type(16)));
typedef unsigned u32x4 __attribute__((ext_vector_type(4)));
typedef unsigned u32x2 __attribute__((ext_vector_type(2)));
typedef __bf16 bf16x2_t __attribute__((ext_vector_type(2)));
typedef float f32x2_t __attribute__((ext_vector_type(2)));
DI unsigned pk2(float a, float b) { f32x2_t v = {a, b}; bf16x2_t r = __builtin_convertvector(v, bf16x2_t); return __builtin_bit_cast(unsigned, r); }
DI float bflo(unsigned u) { return __uint_as_float(u << 16); }
DI float bfhi(unsigned u) { return __uint_as_float(u & 0xffff0000u); }
#define MFMA32(a, b, c) __builtin_amdgcn_mfma_f32_32x32x16_bf16((a), (b), (c), 0, 0, 0)
#define MFMA16(a, b, c) __builtin_amdgcn_mfma_f32_16x16x32_bf16((a), (b), (c), 0, 0, 0)

constexpr int TP = 16384, TS = 512, TT = TP + TS, DM = 2048, DFF = 8192;
constexpr int NIN = 9984;
constexpr int NB = 16, PAST = 1024, NKS = 1056;
constexpr int KVROWS = TP + NB * NKS;
constexpr float EPS = 1e-6f, LOG2E = 1.4426950408889634f;
constexpr int NTHREADS = 512;
constexpr int LDS_BYTES = 147456;
constexpr int XCH_OFF = 131072;

constexpr size_t al256(size_t x) { return (x + 255) & ~(size_t)255; }
constexpr size_t WS_WT_IN = 0;
constexpr size_t WS_WT_OA = WS_WT_IN + al256((size_t)NIN * DM * 2);
constexpr size_t WS_WT_OB = WS_WT_OA + al256((size_t)DM * 1024 * 2);
constexpr size_t WS_WT_OUT = WS_WT_OB + al256((size_t)DM * 1024 * 2);
constexpr size_t WS_WT_FF1 = WS_WT_OUT + al256((size_t)DM * DM * 2);
constexpr size_t WS_WT_FF2 = WS_WT_FF1 + al256((size_t)DFF * DM * 2);
constexpr size_t WS_H = WS_WT_FF2 + al256((size_t)DM * DFF * 2);
constexpr size_t WS_R = WS_H + al256((size_t)TT * DM * 2);
constexpr size_t WS_QA = WS_R;
constexpr size_t WS_QB = WS_QA + al256((size_t)TT * 1024 * 2);
constexpr size_t WS_QI = WS_QB + al256((size_t)TT * 1024 * 2);
constexpr size_t WS_KA = WS_QI + al256((size_t)TT * 1024 * 2);
constexpr size_t WS_VA = WS_KA + al256((size_t)KVROWS * 1024 * 2);
constexpr size_t WS_KB = WS_VA + al256((size_t)KVROWS * 1024 * 2);
constexpr size_t WS_VB = WS_KB + al256((size_t)KVROWS * 256 * 2);
constexpr size_t WS_KI = WS_VB + al256((size_t)KVROWS * 256 * 2);
constexpr size_t WS_WI = WS_KI + al256((size_t)KVROWS * 64 * 2);
constexpr size_t WS_REND = WS_WI + al256((size_t)TT * 16 * 4);
constexpr size_t WS_SELG = WS_REND;
constexpr size_t WS_SELG_END = WS_SELG + al256((size_t)TT * 256 * 4);
constexpr size_t WS_BAR = WS_SELG_END;
constexpr size_t WS_BAR_BYTES = 16384;
constexpr size_t WS_MERGED = WS_QA;
constexpr size_t WS_U = WS_R;
constexpr size_t WS_END = ((WS_BAR + WS_BAR_BYTES) > WS_U + (size_t)TT * DFF * 2) ? (WS_BAR + WS_BAR_BYTES) : (WS_U + al256((size_t)TT * DFF * 2));
static_assert(WS_QB + al256((size_t)TT * 1024 * 2) >= WS_MERGED + (size_t)TT * DM * 2, "merged overlay");

constexpr size_t O_Y = 0;
constexpr size_t O_PAK = O_Y + (size_t)TT * DM;
constexpr size_t O_PAV = O_PAK + (size_t)TP * 1024;
constexpr size_t O_PBK = O_PAV + (size_t)TP * 1024;
constexpr size_t O_PBV = O_PBK + (size_t)TP * 256;
constexpr size_t O_PKI = O_PBV + (size_t)TP * 256;
constexpr size_t O_SAK = O_PKI + (size_t)TP * 64;
constexpr size_t O_SAV = O_SAK + (size_t)TS * 1024;
constexpr size_t O_SBK = O_SAV + (size_t)TS * 1024;
constexpr size_t O_SBV = O_SBK + (size_t)TS * 256;
constexpr size_t O_SKI = O_SBV + (size_t)TS * 256;
constexpr size_t O_END = O_SKI + (size_t)TS * 64;

struct Params { const float* in[25]; float* out; unsigned char* ws; int ph_lo, ph_hi; };

DI int kvrow(int r) { if (r < TP) return r; const int s = r - TP; return TP + (s >> 5) * NKS + PAST + (s & 31); }

template <int MODE>
DI void tconv_tile(const float* __restrict__ src, int Ns, bf16_t* __restrict__ dst, int K, int kt, int nt, float* tile) {
    const int tid = threadIdx.x, k0 = kt * 64, n0 = nt * 64;
#pragma unroll
    for (int i = 0; i < 8; ++i) {
        const int k = i * 8 + (tid >> 6), n = tid & 63; int sc = n0 + n;
        if (MODE == 1) sc = (sc < 5712) ? sc : ((sc < 5888) ? -1 : sc - 176);
        tile[k * 65 + n] = (sc >= 0) ? src[(size_t)(k0 + k) * Ns + sc] : 0.f;
    }
    __syncthreads();
#pragma unroll
    for (int i = 0; i < 4; ++i) {
        const int n = i * 16 + (tid >> 5), kp = tid & 31;
        const float v0 = tile[(2 * kp) * 65 + n], v1 = tile[(2 * kp + 1) * 65 + n];
        *(unsigned*)(dst + (size_t)(n0 + n) * K + k0 + 2 * kp) = pk2(v0, v1);
    }
    __syncthreads();
}

DI float wave_sum(float v) {
#pragma unroll
    for (int o = 1; o < 64; o <<= 1) v += __shfl_xor(v, o);
    return v;
}

DI void rmsnorm_rows(const float* __restrict__ srcA, const float* __restrict__ srcB, const float* __restrict__ g, bf16_t* __restrict__ dst, int G, int c) {
    const int lane = threadIdx.x & 63, wave = __builtin_amdgcn_readfirstlane(threadIdx.x >> 6);
    for (int r = c * 8 + wave; r < TT; r += G * 8) {
        const float* s = (r < TP) ? srcA + (size_t)r * DM : srcB + (size_t)(r - TP) * DM;
        f32x4 v[8]; float ss = 0.f;
#pragma unroll
        for (int i = 0; i < 8; ++i) { v[i] = *(const f32x4*)(s + i * 256 + lane * 4); ss += v[i][0] * v[i][0] + v[i][1] * v[i][1] + v[i][2] * v[i][2] + v[i][3] * v[i][3]; }
        ss = wave_sum(ss);
        const float rs = rsqrtf(ss * (1.0f / DM) + EPS);
#pragma unroll
        for (int i = 0; i < 8; ++i) {
            const f32x4 gg = *(const f32x4*)(g + i * 256 + lane * 4);
            u32x2 w; w.x = pk2(v[i][0] * rs * gg[0], v[i][1] * rs * gg[1]); w.y = pk2(v[i][2] * rs * gg[2], v[i][3] * rs * gg[3]);
            *(u32x2*)(dst + (size_t)r * DM + i * 256 + lane * 4) = w;
        }
    }
}

DI void cache_conv(const float* __restrict__ src, bf16_t* __restrict__ dst, int W, int G, int c) {
    const size_t n8 = (size_t)NB * PAST * W / 8;
    for (size_t i = (size_t)c * NTHREADS + threadIdx.x; i < n8; i += (size_t)G * NTHREADS) {
        const size_t e = i * 8; const int row = (int)(e / W), col = (int)(e % W);
        const f32x4 a = *(const f32x4*)(src + e), b = *(const f32x4*)(src + e + 4);
        u32x4 w; w.x = pk2(a[0], a[1]); w.y = pk2(a[2], a[3]); w.z = pk2(b[0], b[1]); w.w = pk2(b[2], b[3]);
        const int drow = TP + (row >> 10) * NKS + (row & 1023);
        *(u32x4*)(dst + (size_t)drow * W + col) = w;
    }
}

DI void p0_prep(const Params& P, unsigned char* lds, int G, int c) {
    unsigned char* ws = P.ws;
    float* tile = (float*)lds;
    const int nt0 = 32 * 156, nt1 = 16 * 32, nt3 = 32 * 32, nt4 = 32 * 128, nt5 = 128 * 32;
    const int tot = nt0 + 2 * nt1 + nt3 + nt4 + nt5;
    for (int t = c; t < tot; t += G) {
        int u = t;
        if (u < nt0) { tconv_tile<1>(P.in[9], 9808, (bf16_t*)(ws + WS_WT_IN), DM, u & 31, u >> 5, tile); continue; }
        u -= nt0;
        if (u < nt1) { tconv_tile<0>(P.in[19], DM, (bf16_t*)(ws + WS_WT_OA), 1024, u & 15, u >> 4, tile); continue; }
        u -= nt1;
        if (u < nt1) { tconv_tile<0>(P.in[20], DM, (bf16_t*)(ws + WS_WT_OB), 1024, u & 15, u >> 4, tile); continue; }
        u -= nt1;
        if (u < nt3) { tconv_tile<0>(P.in[21], DM, (bf16_t*)(ws + WS_WT_OUT), DM, u & 31, u >> 5, tile); continue; }
        u -= nt3;
        if (u < nt4) { tconv_tile<0>(P.in[23], DFF, (bf16_t*)(ws + WS_WT_FF1), DM, u & 31, u >> 5, tile); continue; }
        u -= nt4;
        tconv_tile<0>(P.in[24], DM, (bf16_t*)(ws + WS_WT_FF2), DFF, u & 127, u >> 7, tile);
    }
    rmsnorm_rows(P.in[0], P.in[1], P.in[8], (bf16_t*)(ws + WS_H), G, c);
    cache_conv(P.in[2], (bf16_t*)(ws + WS_KA), 1024, G, c);
    cache_conv(P.in[3], (bf16_t*)(ws + WS_VA), 1024, G, c);
    cache_conv(P.in[4], (bf16_t*)(ws + WS_KB), 256, G, c);
    cache_conv(P.in[5], (bf16_t*)(ws + WS_VB), 256, G, c);
    cache_conv(P.in[6], (bf16_t*)(ws + WS_KI), 64, G, c);
}

struct OrderRounds { pg8::StaticOrder S; int rounds;
    DI bool next(int i, pg8::Unit& u) const { return i < rounds && S.next(i, u); }
    DI void a_ready(const pg8::Unit&) const {} DI void done(const pg8::Unit&) const {} };
struct OrderOne { pg8::StaticOrder S; int L;
    DI bool next(int i, pg8::Unit& u) const { if (i != 0) return false; return S.at((long)L, u); }
    DI void a_ready(const pg8::Unit&) const {} DI void done(const pg8::Unit&) const {} };

DI float sigmoidf_(float x) { return 1.0f / (1.0f + __expf(-x)); }

struct EpiInProj {
    static constexpr bool PERM = true, AFTER_DRAIN = false;
    float* out; unsigned char* ws; const float* g_qa; const float* g_ka; const float* g_qb; const float* g_kb; float* xch;
    DI void operator()(const f32x4 (&acc)[2][2][4][2], const pg8::Unit& u, int wr, int wc, int fr, int fq) const {
        const int pn = u.pn, pm = u.pm;
        const bool samp = (pm >= 64);
        int rowl0 = wr * 64 + fr, lc0 = wc * 32 + 8 * fq;
        asm volatile("" : "+v"(rowl0), "+v"(lc0));
        int norm = 0; const float* gain = nullptr; float post = 1.f; bool sig = false;
        float* f32p = nullptr; int f32ld = 0; bf16_t* b16p = nullptr; int b16ld = 0; bool kvm = false; int cb = 0;
        if (pn < 4)       { norm = 64; gain = g_qa; post = 0.125f; b16p = (bf16_t*)(ws + WS_QA); b16ld = 1024; cb = pn * 256; }
        else if (pn < 8)  { norm = 64; gain = g_ka; b16p = (bf16_t*)(ws + WS_KA); b16ld = 1024; kvm = true; cb = (pn - 4) * 256; f32p = out + (samp ? O_SAK : O_PAK); f32ld = 1024; }
        else if (pn < 12) { b16p = (bf16_t*)(ws + WS_VA); b16ld = 1024; kvm = true; cb = (pn - 8) * 256; f32p = out + (samp ? O_SAV : O_PAV); f32ld = 1024; }
        else if (pn < 16) { norm = 128; gain = g_qb; b16p = (bf16_t*)(ws + WS_QB); b16ld = 1024; cb = (pn - 12) * 256; }
        else if (pn == 16) { norm = 128; gain = g_kb; b16p = (bf16_t*)(ws + WS_KB); b16ld = 256; kvm = true; cb = 0; f32p = out + (samp ? O_SBK : O_PBK); f32ld = 256; }
        else if (pn == 17) { b16p = (bf16_t*)(ws + WS_VB); b16ld = 256; kvm = true; cb = 0; f32p = out + (samp ? O_SBV : O_PBV); f32ld = 256; }
        else if (pn < 22) { b16p = (bf16_t*)(ws + WS_QI); b16ld = 1024; cb = (pn - 18) * 256; }
        else if (pn == 22) {
#pragma unroll
            for (int ai = 0; ai < 2; ++ai)
#pragma unroll
                for (int m = 0; m < 4; ++m) {
                    const int r = pm * 256 + ai * 128 + m * 16 + rowl0;
                    const f32x4 v0 = acc[ai][0][m][0], v1 = acc[ai][0][m][1];
                    if (lc0 < 64) {
                        float* fo = out + (samp ? O_SKI + (size_t)(r - TP) * 64 : O_PKI + (size_t)r * 64) + lc0;
                        *(f32x4*)fo = v0; *(f32x4*)(fo + 4) = v1;
                        u32x4 w; w.x = pk2(v0[0], v0[1]); w.y = pk2(v0[2], v0[3]); w.z = pk2(v1[0], v1[1]); w.w = pk2(v1[2], v1[3]);
                        *(u32x4*)((bf16_t*)(ws + WS_KI) + (size_t)kvrow(r) * 64 + lc0) = w;
                    } else if (lc0 < 80) {
                        float* fo = (float*)(ws + WS_WI) + (size_t)r * 16 + (lc0 - 64);
                        *(f32x4*)fo = v0; *(f32x4*)(fo + 4) = v1;
                    }
                }
            return;
        }
        else if (pn < 31) { sig = true; b16p = (bf16_t*)(out + O_Y); b16ld = 4096; cb = (pn - 23) * 256; }
        else              { sig = true; b16p = (bf16_t*)(out + O_Y); b16ld = 4096; cb = 2048 + (pn - 31) * 256; }

        if (norm) {
#pragma unroll
            for (int ai = 0; ai < 2; ++ai)
#pragma unroll
                for (int m = 0; m < 4; ++m)
#pragma unroll
                    for (int bj = 0; bj < 2; ++bj) {
                        const f32x4 a = acc[ai][bj][m][0], b = acc[ai][bj][m][1];
                        float ss = a[0] * a[0] + a[1] * a[1] + a[2] * a[2] + a[3] * a[3] + b[0] * b[0] + b[1] * b[1] + b[2] * b[2] + b[3] * b[3];
                        ss += __shfl_xor(ss, 16); ss += __shfl_xor(ss, 32);
                        if (fq == 0) xch[(ai * 128 + m * 16 + rowl0) * 8 + bj * 4 + wc] = ss;
                    }
            __syncthreads();
        }
        f32x4 g0 = {1.f, 1.f, 1.f, 1.f}, g1 = {1.f, 1.f, 1.f, 1.f};
        if (norm) { g0 = *(const f32x4*)(gain + lc0); g1 = *(const f32x4*)(gain + lc0 + 4); }
#pragma unroll
        for (int ai = 0; ai < 2; ++ai)
#pragma unroll
            for (int m = 0; m < 4; ++m) {
                const int rl = ai * 128 + m * 16 + rowl0, r = pm * 256 + rl;
                const size_t brow = kvm ? (size_t)kvrow(r) : (size_t)r;
                const size_t frow = samp ? (size_t)(r - TP) : (size_t)r;
#pragma unroll
                for (int bj = 0; bj < 2; ++bj) {
                    f32x4 v0 = acc[ai][bj][m][0], v1 = acc[ai][bj][m][1];
                    if (norm) {
                        const f32x4 p4 = *(const f32x4*)(xch + rl * 8 + bj * 4);
                        float s;
                        if (norm == 64) s = (wc & 2) ? (p4[2] + p4[3]) : (p4[0] + p4[1]); else s = (p4[0] + p4[1]) + (p4[2] + p4[3]);
                        const float rs = rsqrtf(s * (norm == 64 ? (1.0f / 64.0f) : (1.0f / 128.0f)) + EPS);
                        v0 = v0 * rs * g0; v1 = v1 * rs * g1;
                    }
                    if (sig) { for (int e = 0; e < 4; ++e) { v0[e] = sigmoidf_(v0[e]); v1[e] = sigmoidf_(v1[e]); } }
                    const int col = cb + bj * 128 + lc0;
                    if (f32p) { float* fo = f32p + frow * f32ld + col; *(f32x4*)fo = v0; *(f32x4*)(fo + 4) = v1; }
                    v0 = v0 * post; v1 = v1 * post;
                    u32x4 w; w.x = pk2(v0[0], v0[1]); w.y = pk2(v0[2], v0[3]); w.z = pk2(v1[0], v1[1]); w.w = pk2(v1[2], v1[3]);
                    *(u32x4*)(b16p + brow * b16ld + col) = w;
                }
            }
    }
};

template <int PASS> struct EpiMerge {
    static constexpr bool PERM = true, AFTER_DRAIN = false;
    const bf16_t* gate; bf16_t* merged;
    DI void operator()(const f32x4 (&acc)[2][2][4][2], const pg8::Unit& u, int wr, int wc, int fr, int fq) const {
        const int rowl0 = wr * 64 + fr, lc0 = wc * 32 + 8 * fq;
#pragma unroll
        for (int ai = 0; ai < 2; ++ai)
#pragma unroll
            for (int m = 0; m < 4; ++m) {
                const size_t r = (size_t)u.pm * 256 + ai * 128 + m * 16 + rowl0;
#pragma unroll
                for (int bj = 0; bj < 2; ++bj) {
                    const int col = u.pn * 256 + bj * 128 + lc0;
                    const u32x4 gw = *(const u32x4*)(gate + r * 4096 + PASS * 2048 + col);
                    f32x4 v0 = acc[ai][bj][m][0], v1 = acc[ai][bj][m][1];
                    v0[0] *= bflo(gw.x); v0[1] *= bfhi(gw.x); v0[2] *= bflo(gw.y); v0[3] *= bfhi(gw.y);
                    v1[0] *= bflo(gw.z); v1[1] *= bfhi(gw.z); v1[2] *= bflo(gw.w); v1[3] *= bfhi(gw.w);
                    bf16_t* mp = merged + r * DM + col;
                    if (PASS == 1) {
                        const u32x4 t = *(const u32x4*)mp;
                        v0[0] += bflo(t.x); v0[1] += bfhi(t.x); v0[2] += bflo(t.y); v0[3] += bfhi(t.y);
                        v1[0] += bflo(t.z); v1[1] += bfhi(t.z); v1[2] += bflo(t.w); v1[3] += bfhi(t.w);
                    }
                    u32x4 w; w.x = pk2(v0[0], v0[1]); w.y = pk2(v0[2], v0[3]); w.z = pk2(v1[0], v1[1]); w.w = pk2(v1[2], v1[3]);
                    *(u32x4*)mp = w;
                }
            }
    }
};

struct EpiOut {
    static constexpr bool PERM = true, AFTER_DRAIN = false;
    const float* xp; const float* xs; float* y;
    DI void operator()(const f32x4 (&acc)[2][2][4][2], const pg8::Unit& u, int wr, int wc, int fr, int fq) const {
        const int rowl0 = wr * 64 + fr, lc0 = wc * 32 + 8 * fq;
#pragma unroll
        for (int ai = 0; ai < 2; ++ai)
#pragma unroll
            for (int m = 0; m < 4; ++m) {
                const int r = u.pm * 256 + ai * 128 + m * 16 + rowl0;
                const float* xr = (r < TP) ? xp + (size_t)r * DM : xs + (size_t)(r - TP) * DM;
#pragma unroll
                for (int bj = 0; bj < 2; ++bj) {
                    const int col = u.pn * 256 + bj * 128 + lc0;
                    const f32x4 a = *(const f32x4*)(xr + col), b = *(const f32x4*)(xr + col + 4);
                    float* yo = y + (size_t)r * DM + col;
                    *(f32x4*)yo = acc[ai][bj][m][0] + a; *(f32x4*)(yo + 4) = acc[ai][bj][m][1] + b;
                }
            }
    }
};

struct EpiFF1 {
    static constexpr bool PERM = true, AFTER_DRAIN = false;
    bf16_t* U;
    DI void operator()(const f32x4 (&acc)[2][2][4][2], const pg8::Unit& u, int wr, int wc, int fr, int fq) const {
        const int rowl0 = wr * 64 + fr, lc0 = wc * 32 + 8 * fq;
#pragma unroll
        for (int ai = 0; ai < 2; ++ai)
#pragma unroll
            for (int m = 0; m < 4; ++m) {
                const size_t r = (size_t)u.pm * 256 + ai * 128 + m * 16 + rowl0;
#pragma unroll
                for (int bj = 0; bj < 2; ++bj) {
                    const int col = u.pn * 256 + bj * 128 + lc0;
                    f32x4 v0 = acc[ai][bj][m][0], v1 = acc[ai][bj][m][1];
#pragma unroll
                    for (int e = 0; e < 4; ++e) { const float a = fmaxf(v0[e], 0.f), b = fmaxf(v1[e], 0.f); v0[e] = a * a; v1[e] = b * b; }
                    u32x4 w; w.x = pk2(v0[0], v0[1]); w.y = pk2(v0[2], v0[3]); w.z = pk2(v1[0], v1[1]); w.w = pk2(v1[2], v1[3]);
                    *(u32x4*)(U + r * DFF + col) = w;
                }
            }
    }
};

struct EpiFF2Part {
    static constexpr bool PERM = true, AFTER_DRAIN = false;
    float* part;
    DI void operator()(const f32x4 (&acc)[2][2][4][2], const pg8::Unit& u, int wr, int wc, int fr, int fq) const {
        const int rowl0 = wr * 64 + fr, lc0 = wc * 32 + 8 * fq;
#pragma unroll
        for (int ai = 0; ai < 2; ++ai)
#pragma unroll
            for (int m = 0; m < 4; ++m) {
                const int rl = ai * 128 + m * 16 + rowl0;
#pragma unroll
                for (int bj = 0; bj < 2; ++bj) {
                    float* po = part + rl * 256 + bj * 128 + lc0;
                    *(f32x4*)po = acc[ai][bj][m][0]; *(f32x4*)(po + 4) = acc[ai][bj][m][1];
                }
            }
    }
};

struct EpiFF2 {
    static constexpr bool PERM = true, AFTER_DRAIN = false;
    float* y;
    DI void operator()(const f32x4 (&acc)[2][2][4][2], const pg8::Unit& u, int wr, int wc, int fr, int fq) const {
        const int rowl0 = wr * 64 + fr, lc0 = wc * 32 + 8 * fq;
#pragma unroll
        for (int ai = 0; ai < 2; ++ai)
#pragma unroll
            for (int m = 0; m < 4; ++m) {
                const size_t r = (size_t)u.pm * 256 + ai * 128 + m * 16 + rowl0;
#pragma unroll
                for (int bj = 0; bj < 2; ++bj) {
                    const int col = u.pn * 256 + bj * 128 + lc0;
                    float* yo = y + r * DM + col;
                    const f32x4 a = *(const f32x4*)yo, b = *(const f32x4*)(yo + 4);
                    *(f32x4*)yo = acc[ai][bj][m][0] + a; *(f32x4*)(yo + 4) = acc[ai][bj][m][1] + b;
                }
            }
    }
};
#define LAS __attribute__((address_space(3)))
#define XB_TMO      128
#define XB_XCNT(j)  (256  + 64 * (j))
#define XB_XSUB(j)  (1280 + 64 * (j))
#define XB_XGEN(j)  (2304 + 64 * (j))
#define XB_TOP      3328
#define XB_TOPGEN   3392
#define XCD_BAR_WORDS 3456
#define XB_SPIN_CAP (1u << 18)

__device__ __forceinline__ unsigned xb_ld(unsigned* p)              { return __hip_atomic_load(p, __ATOMIC_RELAXED, __HIP_MEMORY_SCOPE_AGENT); }
__device__ __forceinline__ unsigned xb_add(unsigned* p, unsigned v) { return __hip_atomic_fetch_add(p, v, __ATOMIC_RELAXED, __HIP_MEMORY_SCOPE_AGENT); }
__device__ __forceinline__ unsigned xb_xcc_id() { return (unsigned)__builtin_amdgcn_s_getreg((3 << 11) | 20) & 0xFu; }
#define XB_SPIN(cond, bar) do { unsigned _sp = 0; while (cond) { __builtin_amdgcn_s_sleep(1); \
    if ((++_sp & 255u) == 0u) { if (xb_ld(&(bar)[XB_TMO])) break; if (_sp > XB_SPIN_CAP) { atomicAdd(&(bar)[XB_TMO], 1u); break; } } } } while (0)

struct XcdBarrier {
    unsigned* bar; unsigned x;
    volatile LAS unsigned* st;
};

__device__ __forceinline__ XcdBarrier xcd_barrier_post(unsigned* bar, volatile LAS unsigned* st) {
    XcdBarrier b; b.bar = bar; b.x = xb_xcc_id(); b.st = st;
    if (threadIdx.x == 0) (void)xb_add(&bar[XB_XCNT(b.x)], 1u);
    return b;
}
__device__ __forceinline__ void xcd_barrier_complete(unsigned* bar, unsigned x, unsigned& nloc, unsigned& nx) {
    const unsigned G = gridDim.x * gridDim.y * gridDim.z;
    unsigned sum, cnt, mine, sp = 0u;
    for (;;) {
        sum = 0u; cnt = 0u; mine = 0u;
#pragma unroll
        for (unsigned j = 0; j < 16; ++j) { const unsigned c = xb_ld(&bar[XB_XCNT(j)]); sum += c; cnt += (c > 0u) ? 1u : 0u; mine = (j == x) ? c : mine; }
        if (sum == G) break;
        __builtin_amdgcn_s_sleep(1);
        if ((++sp & 255u) == 0u) { if (xb_ld(&bar[XB_TMO])) break; if (sp > XB_SPIN_CAP) { atomicAdd(&bar[XB_TMO], 1u); break; } }
    }
    nloc = mine > 0u ? mine : 1u; nx = cnt > 0u ? cnt : 1u;
}

__device__ __forceinline__ void xcd_barrier(const XcdBarrier& b) {
    asm volatile("s_waitcnt vmcnt(0)" ::: "memory");
    __syncthreads();
    if (threadIdx.x == 0) {
        unsigned* bar = b.bar;
        __builtin_amdgcn_s_waitcnt(0);
        unsigned nloc = b.st[0], nx = b.st[1];
        if (nloc == 0u) { xcd_barrier_complete(bar, b.x, nloc, nx); b.st[0] = nloc; b.st[1] = nx; }
        const unsigned old = xb_add(&bar[XB_XSUB(b.x)], 1u);
        const unsigned gen = old / nloc;
        if (old + 1u == (gen + 1u) * nloc) {
            __builtin_amdgcn_fence(__ATOMIC_RELEASE, "agent");
            asm volatile("s_waitcnt vmcnt(0)" ::: "memory");
            const unsigned og = xb_add(&bar[XB_TOP], 1u);
            const unsigned tg = og / nx;
            if (og + 1u == (tg + 1u) * nx) xb_add(&bar[XB_TOPGEN], 1u);
            else XB_SPIN(xb_ld(&bar[XB_TOPGEN]) == tg, bar);
            __builtin_amdgcn_fence(__ATOMIC_ACQUIRE, "agent");
            xb_add(&bar[XB_XGEN(b.x)], 1u);
            asm volatile("s_waitcnt vmcnt(0)" ::: "memory");
        } else {
            XB_SPIN(xb_ld(&bar[XB_XGEN(b.x)]) == gen, bar);
            __builtin_amdgcn_fence(__ATOMIC_ACQUIRE, "agent");
            asm volatile("s_waitcnt vmcnt(0)" ::: "memory");
        }
    }
    __syncthreads();
}


DI int t5_bucket(int rel) {
    const int n = rel < 0 ? -rel : rel;
    int b;
    if (n < 8) b = n; else if (n < 12) b = 8; else if (n < 16) b = 9; else if (n < 23) b = 10; else if (n < 32) b = 11;
    else if (n < 46) b = 12; else if (n < 64) b = 13; else if (n < 91) b = 14; else b = 15;
    return b + (rel > 0 ? 16 : 0);
}

constexpr int KROW_B = 272;
constexpr int VROW_B = 136;
constexpr int QROW_B = 272;
constexpr int EXROW_B = 528;
constexpr int A_KS = 0;
constexpr int A_VT = A_KS + 2 * 64 * KROW_B;
constexpr int A_QS = A_VT + 2 * 128 * VROW_B;
constexpr int A_TAB = A_QS + 128 * QROW_B;
constexpr int A_END = A_TAB + 192 * 4;
constexpr int A_EX = 0;
static_assert(A_END <= LDS_BYTES && 128 * EXROW_B <= A_QS, "attention LDS");

struct AttnUnit { int h, qrow0, nq, qpos0, kbase, nkeys; };

#define GLBA_ __attribute__((address_space(1)))
DI void attn_a_unit(const AttnUnit U, const bf16_t* __restrict__ QA, const bf16_t* __restrict__ KA, const bf16_t* __restrict__ VA, bf16_t* __restrict__ OA,
                    const float* __restrict__ rel_bias, const float* __restrict__ subln_g, float lam, float mbound, unsigned char* lds) {
    int tid = threadIdx.x; asm volatile("" : "+v"(tid));
    const int lane = tid & 63, w = __builtin_amdgcn_readfirstlane(tid >> 6), hf = lane >> 5, l31 = lane & 31;
    const int c = w >> 2, wq = w & 3;
    const int h = U.h;
    int ntiles = (U.qpos0 + U.nq - 1) / 64 + 1; { const int nk = (U.nkeys + 63) / 64; ntiles = ntiles < nk ? ntiles : nk; }
    const bool active = (32 * wq < U.nq);
    const int qpos_w = U.qpos0 + 32 * wq;
    const int jmax_w = qpos_w >> 6;
    float* tab = (float*)(lds + A_TAB);
    if (tid < 192) { const int rel = tid - 128; tab[tid] = rel_bias[t5_bucket(rel) * 16 + h] - rel_bias[15 * 16 + h]; }
    {
#pragma unroll
        for (int i = 0; i < 4; ++i) {
            const int idx = i * 512 + tid, row = idx >> 4, seg = idx & 15;
            const int rr = row < U.nq ? row : U.nq - 1;
            const u32x4 v = *(const u32x4*)(QA + (size_t)(U.qrow0 + rr) * 1024 + h * 128 + seg * 8);
            *(u32x4*)(lds + A_QS + row * QROW_B + seg * 16) = v;
        }
    }
    const int k_key = tid >> 3, k_seg = tid & 7;
    const int v_clo = tid & 3, v_kp = ((tid >> 2) & 15) + 16 * ((tid >> 6) & 1), v_c = (tid >> 7) * 4 + v_clo;
    u32x4 kr0, kr1, vr0, vr1, kq0, kq1, vq0, vq1;
    const GLBA_ bf16_t* kgp = (const GLBA_ bf16_t*)(KA + (size_t)(U.kbase + k_key) * 1024 + h * 128 + k_seg * 16);
    const GLBA_ bf16_t* vgp = (const GLBA_ bf16_t*)(VA + (size_t)(U.kbase + 2 * v_kp) * 1024 + h * 128 + v_c * 8);
#define A_LOADK2(j, K0, K1) do { asm volatile("" : "+v"(kgp)); K0 = *(const GLBA_ u32x4*)kgp; K1 = *(const GLBA_ u32x4*)(kgp + 8); kgp += 64 * 1024; } while (0)
#define A_LOADV2(j, V0, V1) do { asm volatile("" : "+v"(vgp)); V0 = *(const GLBA_ u32x4*)vgp; V1 = *(const GLBA_ u32x4*)(vgp + 1024); vgp += 64 * 1024; } while (0)
#define A_STOREK2(b, K0, K1) do { \
        unsigned char* kd_ = lds + A_KS + (b) * 64 * KROW_B + k_key * KROW_B + k_seg * 32; \
        *(u32x4*)kd_ = K0; *(u32x4*)(kd_ + 16) = K1; } while (0)
#define A_STOREV2(b, V0, V1) do { \
        unsigned char* vd_ = lds + A_VT + (b) * 128 * VROW_B + (v_c * 8) * VROW_B + v_kp * 4; \
        *(unsigned*)(vd_ + 0 * VROW_B) = (V0.x & 0xffffu) | (V1.x << 16); *(unsigned*)(vd_ + 1 * VROW_B) = (V0.x >> 16) | (V1.x & 0xffff0000u); \
        *(unsigned*)(vd_ + 2 * VROW_B) = (V0.y & 0xffffu) | (V1.y << 16); *(unsigned*)(vd_ + 3 * VROW_B) = (V0.y >> 16) | (V1.y & 0xffff0000u); \
        *(unsigned*)(vd_ + 4 * VROW_B) = (V0.z & 0xffffu) | (V1.z << 16); *(unsigned*)(vd_ + 5 * VROW_B) = (V0.z >> 16) | (V1.z & 0xffff0000u); \
        *(unsigned*)(vd_ + 6 * VROW_B) = (V0.w & 0xffffu) | (V1.w << 16); *(unsigned*)(vd_ + 7 * VROW_B) = (V0.w >> 16) | (V1.w & 0xffff0000u); } while (0)

    A_LOADK2(0, kr0, kr1); A_STOREK2(0, kr0, kr1); A_LOADV2(0, vr0, vr1); A_STOREV2(0, vr0, vr1);
    A_LOADK2(1, kq0, kq1); A_LOADV2(1, vq0, vq1);
    __syncthreads();

    int oq_ = A_QS + (32 * wq + l31) * QROW_B + hf * 16 + c * 128; asm volatile("" : "+v"(oq_));
    const unsigned char* Qb0 = lds + oq_;
    int ov_ = A_VT + l31 * VROW_B + hf * 8; asm volatile("" : "+v"(ov_));
    int ok_ = A_KS + c * 128 + hf * 16 + l31 * KROW_B; asm volatile("" : "+v"(ok_));
    f32x16 O[4];
#pragma unroll
    for (int nt = 0; nt < 4; ++nt)
#pragma unroll
        for (int i = 0; i < 16; ++i) O[nt][i] = 0.f;
    float lrow = 0.f;
    const float mL = mbound * LOG2E;

    for (int j = 0; j < ntiles; ++j) {
        {
        const int buf = j & 1;
        const bool more = (j + 1 < ntiles);
        A_LOADK2(j + 2, kr0, kr1); A_LOADV2(j + 2, vr0, vr1);
        const bool doit = active && j <= jmax_w;
        bf16x8 pf[2][2];
        if (doit) {
            const unsigned char* Kb = lds + ok_ + buf * 64 * KROW_B;
            const bool near = (64 * j + 63 + 91 > qpos_w);
            const bool lastmask = (64 * j + 64 > U.nkeys);
            f32x16 s0, s1;
#pragma unroll
            for (int i = 0; i < 16; ++i) { s0[i] = 0.f; s1[i] = 0.f; }
#pragma unroll
            for (int ks = 0; ks < 4; ++ks) {
                const bf16x8 qf = *(const bf16x8*)(Qb0 + ks * 32);
                const bf16x8 k0 = *(const bf16x8*)(Kb + ks * 32);
                const bf16x8 k1 = *(const bf16x8*)(Kb + 32 * KROW_B + ks * 32);
                s0 = MFMA32(k0, qf, s0); s1 = MFMA32(k1, qf, s1);
            }
            if (near) {
                const int qp = qpos_w + l31;
#pragma unroll
                for (int i = 0; i < 16; ++i) {
                    const int key = 64 * j + (i & 3) + 8 * (i >> 2) + 4 * hf;
                    int r0 = key - qp, r1 = key + 32 - qp;
                    r0 = r0 < -128 ? -128 : r0; r1 = r1 < -128 ? -128 : r1;
                    s0[i] += tab[r0 + 128]; s1[i] += tab[r1 + 128];
                    if ((i & 3) == 3) __builtin_amdgcn_sched_barrier(0);
                }
            }
            if (lastmask) {
#pragma unroll
                for (int i = 0; i < 16; ++i) {
                    const int key = 64 * j + (i & 3) + 8 * (i >> 2) + 4 * hf;
                    if (key >= U.nkeys) s0[i] = -1e30f;
                    if (key + 32 >= U.nkeys) s1[i] = -1e30f;
                }
            }
            float rs = 0.f;
#pragma unroll
            for (int i = 0; i < 16; ++i) {
                s0[i] = __builtin_amdgcn_exp2f(__builtin_fmaf(s0[i], LOG2E, -mL));
                s1[i] = __builtin_amdgcn_exp2f(__builtin_fmaf(s1[i], LOG2E, -mL));
                rs += s0[i] + s1[i];
            }
            lrow += rs;
#pragma unroll
            for (int s = 0; s < 2; ++s) {
                u32x4 a, b;
                a.x = pk2(s0[8 * s + 0], s0[8 * s + 1]); a.y = pk2(s0[8 * s + 2], s0[8 * s + 3]); a.z = pk2(s0[8 * s + 4], s0[8 * s + 5]); a.w = pk2(s0[8 * s + 6], s0[8 * s + 7]);
                b.x = pk2(s1[8 * s + 0], s1[8 * s + 1]); b.y = pk2(s1[8 * s + 2], s1[8 * s + 3]); b.z = pk2(s1[8 * s + 4], s1[8 * s + 5]); b.w = pk2(s1[8 * s + 6], s1[8 * s + 7]);
                pf[0][s] = __builtin_bit_cast(bf16x8, a); pf[1][s] = __builtin_bit_cast(bf16x8, b);
            }
        }
        A_STOREK2(buf ^ 1, kq0, kq1);
        if (doit) {
#define A_VFRAG2(dst, h_) do { const unsigned char* vrow_ = Vb + ((h_) >> 1) * 32 * VROW_B; \
                _Pragma("unroll") for (int q_ = 0; q_ < 2; ++q_) { const int kb_ = (h_) & 1, s_ = q_; \
                    const u32x2 lo_ = *(const u32x2*)(vrow_ + (kb_ * 32 + 16 * s_) * 2); const u32x2 hi_ = *(const u32x2*)(vrow_ + (kb_ * 32 + 16 * s_ + 8) * 2); \
                    u32x4 vv_; vv_.x = lo_.x; vv_.y = lo_.y; vv_.z = hi_.x; vv_.w = hi_.y; dst[q_] = __builtin_bit_cast(bf16x8, vv_); } } while (0)
            const unsigned char* Vb = lds + ov_ + buf * 128 * VROW_B;
            bf16x8 va[2], vb[2];
            A_VFRAG2(va, 0); A_VFRAG2(vb, 1);
            __builtin_amdgcn_sched_barrier(0);
#pragma unroll
            for (int hh = 0; hh < 8; ++hh) {
                const int nt = hh >> 1, kb = hh & 1;
                if (kb == 0) { O[nt] = MFMA32(va[0], pf[kb][0], O[nt]); O[nt] = MFMA32(va[1], pf[kb][1], O[nt]); }
                else         { O[nt] = MFMA32(vb[0], pf[kb][0], O[nt]); O[nt] = MFMA32(vb[1], pf[kb][1], O[nt]); }
                __builtin_amdgcn_sched_barrier(0);
                if (hh + 2 < 8) { if (kb == 0) A_VFRAG2(va, hh + 2); else A_VFRAG2(vb, hh + 2); }
                __builtin_amdgcn_sched_barrier(0);
            }
#undef A_VFRAG2
        }
        A_STOREV2(buf ^ 1, vq0, vq1);
        __syncthreads();
            }
        ++j; if (j >= ntiles) break;
        {
        const int buf = j & 1;
        const bool more = (j + 1 < ntiles);
        A_LOADK2(j + 2, kq0, kq1); A_LOADV2(j + 2, vq0, vq1);
        const bool doit = active && j <= jmax_w;
        bf16x8 pf[2][2];
        if (doit) {
            const unsigned char* Kb = lds + ok_ + buf * 64 * KROW_B;
            const bool near = (64 * j + 63 + 91 > qpos_w);
            const bool lastmask = (64 * j + 64 > U.nkeys);
            f32x16 s0, s1;
#pragma unroll
            for (int i = 0; i < 16; ++i) { s0[i] = 0.f; s1[i] = 0.f; }
#pragma unroll
            for (int ks = 0; ks < 4; ++ks) {
                const bf16x8 qf = *(const bf16x8*)(Qb0 + ks * 32);
                const bf16x8 k0 = *(const bf16x8*)(Kb + ks * 32);
                const bf16x8 k1 = *(const bf16x8*)(Kb + 32 * KROW_B + ks * 32);
                s0 = MFMA32(k0, qf, s0); s1 = MFMA32(k1, qf, s1);
            }
            if (near) {
                const int qp = qpos_w + l31;
#pragma unroll
                for (int i = 0; i < 16; ++i) {
                    const int key = 64 * j + (i & 3) + 8 * (i >> 2) + 4 * hf;
                    int r0 = key - qp, r1 = key + 32 - qp;
                    r0 = r0 < -128 ? -128 : r0; r1 = r1 < -128 ? -128 : r1;
                    s0[i] += tab[r0 + 128]; s1[i] += tab[r1 + 128];
                    if ((i & 3) == 3) __builtin_amdgcn_sched_barrier(0);
                }
            }
            if (lastmask) {
#pragma unroll
                for (int i = 0; i < 16; ++i) {
                    const int key = 64 * j + (i & 3) + 8 * (i >> 2) + 4 * hf;
                    if (key >= U.nkeys) s0[i] = -1e30f;
                    if (key + 32 >= U.nkeys) s1[i] = -1e30f;
                }
            }
            float rs = 0.f;
#pragma unroll
            for (int i = 0; i < 16; ++i) {
                s0[i] = __builtin_amdgcn_exp2f(__builtin_fmaf(s0[i], LOG2E, -mL));
                s1[i] = __builtin_amdgcn_exp2f(__builtin_fmaf(s1[i], LOG2E, -mL));
                rs += s0[i] + s1[i];
            }
            lrow += rs;
#pragma unroll
            for (int s = 0; s < 2; ++s) {
                u32x4 a, b;
                a.x = pk2(s0[8 * s + 0], s0[8 * s + 1]); a.y = pk2(s0[8 * s + 2], s0[8 * s + 3]); a.z = pk2(s0[8 * s + 4], s0[8 * s + 5]); a.w = pk2(s0[8 * s + 6], s0[8 * s + 7]);
                b.x = pk2(s1[8 * s + 0], s1[8 * s + 1]); b.y = pk2(s1[8 * s + 2], s1[8 * s + 3]); b.z = pk2(s1[8 * s + 4], s1[8 * s + 5]); b.w = pk2(s1[8 * s + 6], s1[8 * s + 7]);
                pf[0][s] = __builtin_bit_cast(bf16x8, a); pf[1][s] = __builtin_bit_cast(bf16x8, b);
            }
        }
        A_STOREK2(buf ^ 1, kr0, kr1);
        if (doit) {
#define A_VFRAG2(dst, h_) do { const unsigned char* vrow_ = Vb + ((h_) >> 1) * 32 * VROW_B; \
                _Pragma("unroll") for (int q_ = 0; q_ < 2; ++q_) { const int kb_ = (h_) & 1, s_ = q_; \
                    const u32x2 lo_ = *(const u32x2*)(vrow_ + (kb_ * 32 + 16 * s_) * 2); const u32x2 hi_ = *(const u32x2*)(vrow_ + (kb_ * 32 + 16 * s_ + 8) * 2); \
                    u32x4 vv_; vv_.x = lo_.x; vv_.y = lo_.y; vv_.z = hi_.x; vv_.w = hi_.y; dst[q_] = __builtin_bit_cast(bf16x8, vv_); } } while (0)
            const unsigned char* Vb = lds + ov_ + buf * 128 * VROW_B;
            bf16x8 va[2], vb[2];
            A_VFRAG2(va, 0); A_VFRAG2(vb, 1);
            __builtin_amdgcn_sched_barrier(0);
#pragma unroll
            for (int hh = 0; hh < 8; ++hh) {
                const int nt = hh >> 1, kb = hh & 1;
                if (kb == 0) { O[nt] = MFMA32(va[0], pf[kb][0], O[nt]); O[nt] = MFMA32(va[1], pf[kb][1], O[nt]); }
                else         { O[nt] = MFMA32(vb[0], pf[kb][0], O[nt]); O[nt] = MFMA32(vb[1], pf[kb][1], O[nt]); }
                __builtin_amdgcn_sched_barrier(0);
                if (hh + 2 < 8) { if (kb == 0) A_VFRAG2(va, hh + 2); else A_VFRAG2(vb, hh + 2); }
                __builtin_amdgcn_sched_barrier(0);
            }
#undef A_VFRAG2
        }
        A_STOREV2(buf ^ 1, vr0, vr1);
        __syncthreads();
            }
    }
#undef A_LOADK2
#undef A_LOADV2
#undef A_STOREK2
#undef A_STOREV2
    const float ltot = lrow + __shfl_xor(lrow, 32);
    const float sc = (c == 0 ? 1.0f : lam) / ltot;
    unsigned char* exrow = lds + A_EX + (32 * wq + l31) * EXROW_B;
    if (active && c == 1) {
#pragma unroll
        for (int nt = 0; nt < 4; ++nt)
#pragma unroll
            for (int a = 0; a < 4; ++a) {
                f32x4 v = {O[nt][4 * a] * sc, O[nt][4 * a + 1] * sc, O[nt][4 * a + 2] * sc, O[nt][4 * a + 3] * sc};
                *(f32x4*)(exrow + (nt * 32 + 8 * a + 4 * hf) * 4) = v;
            }
    }
    __syncthreads();
    if (active && c == 0) {
        float ss = 0.f;
#pragma unroll
        for (int nt = 0; nt < 4; ++nt)
#pragma unroll
            for (int a = 0; a < 4; ++a) {
                const f32x4 v = *(const f32x4*)(exrow + (nt * 32 + 8 * a + 4 * hf) * 4);
#pragma unroll
                for (int e = 0; e < 4; ++e) { const float o = O[nt][4 * a + e] * sc - v[e]; O[nt][4 * a + e] = o; ss += o * o; }
            }
        ss += __shfl_xor(ss, 32);
        const float rs = rsqrtf(ss * (1.0f / 128.0f) + EPS) * 0.8f;
        bf16_t* orow = OA + (size_t)(U.qrow0 + 32 * wq + l31) * 1024 + h * 128;
#pragma unroll
        for (int nt = 0; nt < 4; ++nt)
#pragma unroll
            for (int a = 0; a < 4; ++a) {
                const int dv = nt * 32 + 8 * a + 4 * hf;
                const f32x4 g = *(const f32x4*)(subln_g + dv);
                u32x2 wv; wv.x = pk2(O[nt][4 * a + 0] * rs * g[0], O[nt][4 * a + 1] * rs * g[1]); wv.y = pk2(O[nt][4 * a + 2] * rs * g[2], O[nt][4 * a + 3] * rs * g[3]);
                *(u32x2*)(orow + dv) = wv;
            }
    }
    __syncthreads();
}

DI void attn_a_phase(const Params& P, unsigned char* lds, int G, int c) {
    unsigned char* ws = P.ws;
    const bf16_t* QA = (const bf16_t*)(ws + WS_QA); const bf16_t* KA = (const bf16_t*)(ws + WS_KA); const bf16_t* VA = (const bf16_t*)(ws + WS_VA);
    bf16_t* OA = (bf16_t*)(ws + WS_H);
    float lam;
    {
        int lane = threadIdx.x & 63; asm volatile("" : "+v"(lane));
        const float a = wave_sum(P.in[12][lane] * P.in[13][lane]), b = wave_sum(P.in[14][lane] * P.in[15][lane]);
        lam = __expf(a) - __expf(b) + 0.2f;
    }
    float mbound;
    {
        int lane = threadIdx.x & 63; asm volatile("" : "+v"(lane));
        float gq = fmaxf(fabsf(P.in[10][lane]), fabsf(P.in[10][lane + 64])), gk = fmaxf(fabsf(P.in[11][lane]), fabsf(P.in[11][lane + 64]));
        float bm = 0.f;
        for (int i = lane; i < 32 * 8; i += 64) { const int b = i >> 3, h = i & 7; bm = fmaxf(bm, fabsf(P.in[7][b * 16 + h] - P.in[7][15 * 16 + h])); }
#pragma unroll
        for (int o = 1; o < 64; o <<= 1) { gq = fmaxf(gq, __shfl_xor(gq, o)); gk = fmaxf(gk, __shfl_xor(gk, o)); bm = fmaxf(bm, __shfl_xor(bm, o)); }
        mbound = 8.0f * gq * gk + bm;
    }
    for (int k = c; k < 512; k += G) {
#pragma unroll 1
        for (int half = 0; half < 2; ++half) {
            const int h = k & 7, ii = k >> 3;
            const int i = half ? 127 - ii : ii;
            AttnUnit u{h, 128 * i, 128, 128 * i, 0, TP};
            attn_a_unit(u, QA, KA, VA, OA, P.in[7], P.in[16], lam, mbound, lds);
        }
    }
    for (int su = c; su < NB * 8; su += G) {
        const int h = su & 7, b = su >> 3;
        AttnUnit u{h, TP + 32 * b, 32, PAST, TP + b * NKS, NKS};
        attn_a_unit(u, QA, KA, VA, OA, P.in[7], P.in[16], lam, mbound, lds);
    }
}

constexpr int D_TABB = 0;
constexpr int D_CNT = D_TABB + 8 * 192 * 4;
constexpr int D_WTOT = D_CNT + 2 * 8 * 2 * 4;
constexpr int D_SEL = D_WTOT + 8 * 2 * 4 + 64;
constexpr int D_KST = D_SEL + 4 * 256 * 4;
constexpr int KST_BYTES = 256 * 128;
constexpr int DCAP = 2048;
constexpr int D_CU = D_KST;
constexpr int D_CK = D_CU + 2 * DCAP * 4;
constexpr int D_PN = D_KST + KST_BYTES;
constexpr int D_END = D_KST + 4 * KST_BYTES;
static_assert(D_END <= LDS_BYTES && D_CK + 2 * DCAP * 2 <= D_END, "dsa LDS");

DI void lds_barrier() { asm volatile("s_waitcnt lgkmcnt(0)" ::: "memory"); __builtin_amdgcn_s_barrier(); asm volatile("" ::: "memory"); }
DI unsigned f2sort(float f) { const unsigned u = __float_as_uint(f); return (u & 0x80000000u) ? ~u : (u | 0x80000000u); }
#define NEGKEY 0x007fffffu

DI void dsa_select(int tok0, int kbase, int L, int slot, const bf16_t* __restrict__ QI, const bf16_t* __restrict__ KI, const float* __restrict__ WI, unsigned char* lds) {
    int tid = threadIdx.x; asm volatile("" : "+v"(tid)); int lane = tid & 63;
    const int w = __builtin_amdgcn_readfirstlane(tid >> 6), hf = lane >> 5, l31 = lane & 31;
    const int NT = L >> 5;
    int* cntx = (int*)(lds + D_CNT); int* wtot = (int*)(lds + D_WTOT); int* sel = (int*)(lds + D_SEL);
    unsigned u[64];
    {
        const int r = l31, rq = (r >> 2) & 1, rh = (r >> 3) * 4 + (r & 3);
        bf16x8 qf[4];
#pragma unroll
        for (int ks = 0; ks < 4; ++ks) qf[ks] = *(const bf16x8*)(QI + (size_t)(tok0 + rq) * 1024 + rh * 64 + ks * 16 + hf * 8);
        float wv[16];
#pragma unroll
        for (int i = 0; i < 4; ++i) { const f32x4 t = *(const f32x4*)(WI + (size_t)(tok0 + hf) * 16 + 4 * i); wv[4 * i] = t[0]; wv[4 * i + 1] = t[1]; wv[4 * i + 2] = t[2]; wv[4 * i + 3] = t[3]; }
        int nstage = (NT + 7) >> 3;
        const int krow_ = lane >> 3, x0_ = (lane & 7) ^ (lane >> 4), x1_ = (lane & 7) ^ (4 + (lane >> 4));
        const char* gsrc = (const char*)(KI + (size_t)kbase * 64) + (size_t)(w * 32 + krow_) * 128;
        const int go0 = x0_ * 16, go1 = 8 * 128 + x1_ * 16, go2 = 16 * 128 + x0_ * 16, go3 = 24 * 128 + x1_ * 16;
        PG8_LAS unsigned char* lds3 = (PG8_LAS unsigned char*)lds;
        const int ldst = D_KST + w * 4096;
        const int xr_ = (l31 >> 1) & 7;
        const unsigned char* lrd = lds + D_KST + (w * 32 + l31) * 128;
        const int ro0 = ((0 + hf) ^ xr_) * 16, ro1 = ((2 + hf) ^ xr_) * 16, ro2 = ((4 + hf) ^ xr_) * 16, ro3 = ((6 + hf) ^ xr_) * 16;
#define D_DMA(bi) do { asm volatile("" : "+v"(gsrc)); \
        __builtin_amdgcn_global_load_lds((const unsigned*)(gsrc + go0), (PG8_LAS unsigned*)(lds3 + ldst + (bi) * KST_BYTES), 16, 0, 0); \
        __builtin_amdgcn_global_load_lds((const unsigned*)(gsrc + go1), (PG8_LAS unsigned*)(lds3 + ldst + (bi) * KST_BYTES + 1024), 16, 0, 0); \
        __builtin_amdgcn_global_load_lds((const unsigned*)(gsrc + go2), (PG8_LAS unsigned*)(lds3 + ldst + (bi) * KST_BYTES + 2048), 16, 0, 0); \
        __builtin_amdgcn_global_load_lds((const unsigned*)(gsrc + go3), (PG8_LAS unsigned*)(lds3 + ldst + (bi) * KST_BYTES + 3072), 16, 0, 0); \
        gsrc += KST_BYTES; } while (0)
        D_DMA(0); D_DMA(1);
        asm volatile("s_waitcnt vmcnt(0)" ::: "memory"); __builtin_amdgcn_s_barrier(); asm volatile("" ::: "memory");
#pragma unroll
        for (int g = 0; g < 8; ++g) {
            asm volatile("" : "+s"(nstage));
            if (nstage > 8 * g) {
#pragma unroll
                for (int e = 0; e < 4; ++e) {
                    const int sa = g * 8 + 2 * e, sb = sa + 1;
                    const int boa = (sa & 3) * KST_BYTES, bob = (sb & 3) * KST_BYTES;
                    D_DMA((sa + 2) & 3); D_DMA((sb + 2) & 3);
                    f32x16 da, db;
#pragma unroll
                    for (int i = 0; i < 16; ++i) { da[i] = 0.f; db[i] = 0.f; }
                    { const bf16x8 a0 = *(const bf16x8*)(lrd + boa + ro0), a1 = *(const bf16x8*)(lrd + boa + ro1), a2 = *(const bf16x8*)(lrd + boa + ro2), a3 = *(const bf16x8*)(lrd + boa + ro3);
                      const bf16x8 b0 = *(const bf16x8*)(lrd + bob + ro0), b1 = *(const bf16x8*)(lrd + bob + ro1), b2 = *(const bf16x8*)(lrd + bob + ro2), b3 = *(const bf16x8*)(lrd + bob + ro3);
                      da = MFMA32(qf[0], a0, da); db = MFMA32(qf[0], b0, db); da = MFMA32(qf[1], a1, da); db = MFMA32(qf[1], b1, db);
                      da = MFMA32(qf[2], a2, da); db = MFMA32(qf[2], b2, db); da = MFMA32(qf[3], a3, da); db = MFMA32(qf[3], b3, db); }
                    float sa0 = 0.f, sa1 = 0.f, sb0 = 0.f, sb1 = 0.f;
#pragma unroll
                    for (int i = 0; i < 8; ++i) {
                        sa0 = __builtin_fmaf(wv[2 * i], __builtin_amdgcn_fmed3f(da[2 * i], 0.f, __builtin_inff()), sa0); sa1 = __builtin_fmaf(wv[2 * i + 1], __builtin_amdgcn_fmed3f(da[2 * i + 1], 0.f, __builtin_inff()), sa1);
                        sb0 = __builtin_fmaf(wv[2 * i], __builtin_amdgcn_fmed3f(db[2 * i], 0.f, __builtin_inff()), sb0); sb1 = __builtin_fmaf(wv[2 * i + 1], __builtin_amdgcn_fmed3f(db[2 * i + 1], 0.f, __builtin_inff()), sb1);
                    }
                    u[sa] = (sa * 8 + w < NT) ? f2sort(sa0 + sa1) : NEGKEY;
                    u[sb] = (sb * 8 + w < NT) ? f2sort(sb0 + sb1) : NEGKEY;
                    asm volatile("s_waitcnt vmcnt(0)\n\ts_waitcnt lgkmcnt(0)" ::: "memory"); __builtin_amdgcn_s_barrier(); asm volatile("" ::: "memory");
                }
            } else {
#pragma unroll
                for (int e = 0; e < 8; ++e) u[g * 8 + e] = NEGKEY;
            }
        }
#undef D_DMA
    }
    const int nsel = L < 256 ? L : 256;
    unsigned* candU = (unsigned*)(lds + D_CU); unsigned short* candK = (unsigned short*)(lds + D_CK);
    bool fast = false;
    unsigned LB = 0u; int cbase = 0, cexcl = 0, ctot0 = 0, ctot1 = 0;
    if (L > 256) {
        unsigned m1 = u[0], m2 = 0u;
#pragma unroll
        for (int i = 1; i < 64; ++i) { const unsigned lo_ = m1 < u[i] ? m1 : u[i]; m2 = m2 > lo_ ? m2 : lo_; m1 = m1 > u[i] ? m1 : u[i]; }
        const unsigned p1 = (unsigned)__shfl_xor((int)m1, 1), p2 = (unsigned)__shfl_xor((int)m2, 1);
        const unsigned mx = m1 > p1 ? m1 : p1;
        const unsigned lo1 = m1 < p1 ? m1 : p1, hi2 = m2 > p2 ? m2 : p2;
        unsigned mn = lo1 > hi2 ? lo1 : hi2;
#pragma unroll
        for (int o = 1; o < 32; o <<= 1) { const unsigned t = (unsigned)__shfl_xor((int)mn, o); mn = mn < t ? mn : t; }
        unsigned mxx = mx;
#pragma unroll
        for (int o = 1; o < 32; o <<= 1) { const unsigned t = (unsigned)__shfl_xor((int)mxx, o); mxx = mxx > t ? mxx : t; }
        if (l31 == 0) { cntx[w * 2 + hf] = (int)mn; cntx[16 + w * 2 + hf] = (int)mxx; }
        __syncthreads();
        LB = (unsigned)cntx[hf];
#pragma unroll
        for (int ww = 1; ww < 8; ++ww) { const unsigned t = (unsigned)cntx[ww * 2 + hf]; LB = LB < t ? LB : t; }
        int cc = 0;
#pragma unroll
        for (int i = 0; i < 64; ++i) cc += (u[i] >= LB) ? 1 : 0;
        int incl = cc;
#pragma unroll
        for (int o = 1; o < 32; o <<= 1) { const int t = __shfl_up(incl, o, 32); if (l31 >= o) incl += t; }
        if (l31 == 31) wtot[w * 2 + hf] = incl;
        __syncthreads();
#pragma unroll
        for (int ww = 0; ww < 8; ++ww) { const int t0 = wtot[ww * 2], t1 = wtot[ww * 2 + 1]; ctot0 += t0; ctot1 += t1; if (ww < w) cbase += hf ? t1 : t0; }
        cexcl = incl - cc;
        fast = (ctot0 <= DCAP) && (ctot1 <= DCAP);
    }
    if (fast) {
        {
            int pos = cbase + cexcl;
            asm volatile("" : "+v"(LB));
#pragma unroll
            for (int i = 0; i < 64; ++i) if (u[i] >= LB) { candU[hf * DCAP + pos] = u[i]; candK[hf * DCAP + pos] = (unsigned short)((i * 8 + w) * 32 + l31); ++pos; }
        }
        __syncthreads();
        const int qq = w >> 2, ts = tid & 255, ntot = qq ? ctot1 : ctot0;
        unsigned cu[8];
#pragma unroll
        for (int k = 0; k < 8; ++k) { const int idx = ts + 256 * k; cu[k] = idx < ntot ? candU[qq * DCAP + idx] : 0u; }
        unsigned* tq = (unsigned*)(lds + D_WTOT) + 16;
        if (w < 2) {
            const int nt_ = w ? ctot1 : ctot0;
            unsigned lbq = (unsigned)cntx[w], mxq = (unsigned)cntx[16 + w];
#pragma unroll
            for (int ww = 1; ww < 8; ++ww) { const unsigned a_ = (unsigned)cntx[ww * 2 + w], b_ = (unsigned)cntx[16 + ww * 2 + w]; lbq = lbq < a_ ? lbq : a_; mxq = mxq > b_ ? mxq : b_; }
            lbq = __builtin_amdgcn_readfirstlane(lbq); mxq = __builtin_amdgcn_readfirstlane(mxq);
            unsigned ce[32];
#pragma unroll
            for (int k = 0; k < 32; ++k) { const int idx = lane + 64 * k; ce[k] = idx < nt_ ? (candU[w * DCAP + idx] - lbq) : 0u; }
            const unsigned span = mxq - lbq;
            const int nb = span ? 32 - __builtin_clz(span) : 0;
            unsigned Tw = 0u;
            int kmax = (nt_ + 63) >> 6;
            for (int bit = nb - 1; bit >= 0; --bit) {
                const unsigned cand = Tw | (1u << bit);
                int cl = 0;
#pragma unroll
                for (int g = 0; g < 4; ++g) {
                    if (kmax > 8 * g) {
#pragma unroll
                        for (int e = 0; e < 8; ++e) cl += (ce[g * 8 + e] >= cand) ? 1 : 0;
                    }
                }
                int n = 0;
#pragma unroll
                for (int b_ = 0; b_ < 6; ++b_) n += __builtin_popcountll(__builtin_amdgcn_ballot_w64(((cl >> b_) & 1) != 0)) << b_;
                if (n == 256) { Tw = cand - 1u; break; }
                if (n > 256) Tw = cand;
            }
            Tw += lbq;
            if (lane == 0) tq[w] = Tw;
        }
        __syncthreads();
        unsigned T = tq[qq];
        int c2 = 0;
#pragma unroll
        for (int k = 0; k < 8; ++k) c2 += (cu[k] > T ? 1 : 0) + (cu[k] == T ? 65536 : 0);
        int incl = c2;
#pragma unroll
        for (int o = 1; o < 64; o <<= 1) { const int t = __shfl_up(incl, o, 64); if (lane >= o) incl += t; }
        if (lane == 63) wtot[w] = incl;
        __syncthreads();
        int base = 0, total = 0;
#pragma unroll
        for (int ww = 0; ww < 4; ++ww) { const int t = wtot[qq * 4 + ww]; total += t; if (ww < (w & 3)) base += t; }
        const int excl = incl - c2;
        int pos_gt = (base & 0xffff) + (excl & 0xffff);
        int pos_eq = (total & 0xffff) + (base >> 16) + (excl >> 16);
        int* sl = sel + (slot + qq) * 256;
        asm volatile("" : "+v"(T));
#pragma unroll
        for (int k = 0; k < 8; ++k) {
            const int idx = ts + 256 * k;
            if (cu[k] > T) { if (pos_gt < 256) sl[pos_gt] = candK[qq * DCAP + idx]; ++pos_gt; }
            else if (cu[k] == T) { if (pos_eq < 256) sl[pos_eq] = candK[qq * DCAP + idx]; ++pos_eq; }
        }
        __syncthreads();
    } else {
        unsigned T = NEGKEY;
        if (L > 256) {
            unsigned T0 = 0u, T1 = 0u;
            int par = 0;
            for (int bit = 31; bit >= 0; --bit) {
                const unsigned c0 = T0 | (1u << bit), c1 = T1 | (1u << bit);
                const unsigned cand = hf ? c1 : c0;
                int cn = 0;
#pragma unroll
                for (int i = 0; i < 64; ++i) cn += (u[i] >= cand) ? 1 : 0;
                cn += __shfl_xor(cn, 1); cn += __shfl_xor(cn, 2); cn += __shfl_xor(cn, 4); cn += __shfl_xor(cn, 8); cn += __shfl_xor(cn, 16);
                if (l31 == 0) cntx[par * 16 + w * 2 + hf] = cn;
                __syncthreads();
                int t0 = 0, t1 = 0;
#pragma unroll
                for (int ww = 0; ww < 8; ++ww) { t0 += cntx[par * 16 + ww * 2]; t1 += cntx[par * 16 + ww * 2 + 1]; }
                if (t0 >= 256) T0 = c0;
                if (t1 >= 256) T1 = c1;
                par ^= 1;
            }
            T = hf ? T1 : T0;
        }
        asm volatile("" : "+v"(T));
        int c2 = 0;
#pragma unroll
        for (int ii = 0; ii < 64; ++ii) c2 += (u[ii] > T ? 1 : 0) + (u[ii] == T ? 65536 : 0);
        int incl = c2;
#pragma unroll
        for (int o = 1; o < 32; o <<= 1) { const int t = __shfl_up(incl, o, 32); if (l31 >= o) incl += t; }
        if (l31 == 31) wtot[w * 2 + hf] = incl;
        __syncthreads();
        int base = 0, total = 0;
#pragma unroll
        for (int ww = 0; ww < 8; ++ww) { const int t = wtot[ww * 2 + hf]; total += t; if (ww < w) base += t; }
        const int excl = incl - c2;
        const int total_gt = total & 0xffff;
        int pos_gt = (base & 0xffff) + (excl & 0xffff);
        int pos_eq = total_gt + (base >> 16) + (excl >> 16);
        int* sl = sel + (slot + hf) * 256;
        asm volatile("" : "+v"(T));
#pragma unroll
        for (int ii = 0; ii < 64; ++ii) {
            const int key = (ii * 8 + w) * 32 + l31;
            if (u[ii] > T) { if (pos_gt < 256) sl[pos_gt] = key; ++pos_gt; }
            else if (u[ii] == T) { if (pos_eq < nsel) sl[pos_eq] = key; ++pos_eq; }
        }
        __syncthreads();
    }
}

DI void dsa_sparse(int tok, int qpos, int kbase, int nsel, int n, const int* sl, float* pw, const float* tabB,
                   const bf16_t* __restrict__ QB, const bf16_t* __restrict__ KB, const bf16_t* __restrict__ VB, bf16_t* __restrict__ OB) {
    int lane = threadIdx.x & 63; asm volatile("" : "+v"(lane));
    {
        const int row = lane & 15, kg = lane >> 4;
        bf16x8 qf[4];
#pragma unroll
        for (int ks = 0; ks < 4; ++ks) {
            u32x4 z = {0u, 0u, 0u, 0u};
            if (row < 4) z = *(const u32x4*)(QB + (size_t)tok * 1024 + (n * 4 + row) * 128 + ks * 32 + kg * 8);
            qf[ks] = __builtin_bit_cast(bf16x8, z);
        }
#pragma unroll 1
        for (int tb = 0; tb < 4; ++tb) {
            bf16x8 kf[4][4]; int keyv[4];
#pragma unroll
            for (int e = 0; e < 4; ++e) {
                const int j = (tb * 4 + e) * 16 + row;
                const int jj = j < nsel ? j : nsel - 1;
                keyv[e] = sl[jj];
                const bf16_t* kp = KB + (size_t)(kbase + keyv[e]) * 256 + n * 128 + kg * 8;
#pragma unroll
                for (int ks = 0; ks < 4; ++ks) kf[e][ks] = *(const bf16x8*)(kp + ks * 32);
            }
#pragma unroll
            for (int e = 0; e < 4; ++e) {
                const int j = (tb * 4 + e) * 16 + row;
                f32x4 d = {0.f, 0.f, 0.f, 0.f};
#pragma unroll
                for (int ks = 0; ks < 4; ++ks) d = MFMA16(qf[ks], kf[e][ks], d);
                int rel = keyv[e] - qpos; rel = rel < -128 ? -128 : rel;
                f32x4 v;
#pragma unroll
                for (int g = 0; g < 4; ++g) { const float x = d[g] * 0.08838834764831845f + tabB[(n * 4 + g) * 192 + rel + 128]; v[g] = (j < nsel) ? x : -1e30f; }
                if (kg == 0) *(f32x4*)(pw + j * 4) = v;
            }
        }
    }
    {
        f32x4 v[4];
#pragma unroll
        for (int e = 0; e < 4; ++e) v[e] = *(const f32x4*)(pw + (e * 64 + lane) * 4);
#pragma unroll
        for (int g = 0; g < 4; ++g) {
            float m = fmaxf(fmaxf(v[0][g], v[1][g]), fmaxf(v[2][g], v[3][g]));
#pragma unroll
            for (int o = 1; o < 64; o <<= 1) m = fmaxf(m, __shfl_xor(m, o));
            float sum = 0.f;
#pragma unroll
            for (int e = 0; e < 4; ++e) { v[e][g] = __expf(v[e][g] - m); sum += v[e][g]; }
            sum = wave_sum(sum);
            const float inv = 1.0f / sum;
#pragma unroll
            for (int e = 0; e < 4; ++e) v[e][g] *= inv;
        }
#pragma unroll
        for (int e = 0; e < 4; ++e) *(f32x4*)(pw + (e * 64 + lane) * 4) = v[e];
    }
    {
        const int ksub = lane >> 4, dc = lane & 15;
        float acc[4][8];
#pragma unroll
        for (int g = 0; g < 4; ++g)
#pragma unroll
            for (int e = 0; e < 8; ++e) acc[g][e] = 0.f;
        const bf16_t* vbase = VB + (size_t)kbase * 256 + n * 128 + dc * 8;
#pragma unroll 1
        for (int j0 = 0; j0 < nsel; j0 += 32) {
            u32x4 vv[8]; f32x4 pp[8];
#pragma unroll
            for (int i = 0; i < 8; ++i) {
                const int j = j0 + i * 4 + ksub;
                const int jj = j < nsel ? j : nsel - 1;
                vv[i] = *(const u32x4*)(vbase + (size_t)sl[jj] * 256);
                pp[i] = *(const f32x4*)(pw + jj * 4);
                if (j >= nsel) pp[i] = (f32x4){0.f, 0.f, 0.f, 0.f};
            }
#pragma unroll
            for (int i = 0; i < 8; ++i) {
                const float x0 = bflo(vv[i].x), x1 = bfhi(vv[i].x), x2 = bflo(vv[i].y), x3 = bfhi(vv[i].y), x4 = bflo(vv[i].z), x5 = bfhi(vv[i].z), x6 = bflo(vv[i].w), x7 = bfhi(vv[i].w);
#pragma unroll
                for (int g = 0; g < 4; ++g) {
                    const float p = pp[i][g];
                    acc[g][0] = __builtin_fmaf(p, x0, acc[g][0]); acc[g][1] = __builtin_fmaf(p, x1, acc[g][1]); acc[g][2] = __builtin_fmaf(p, x2, acc[g][2]); acc[g][3] = __builtin_fmaf(p, x3, acc[g][3]);
                    acc[g][4] = __builtin_fmaf(p, x4, acc[g][4]); acc[g][5] = __builtin_fmaf(p, x5, acc[g][5]); acc[g][6] = __builtin_fmaf(p, x6, acc[g][6]); acc[g][7] = __builtin_fmaf(p, x7, acc[g][7]);
                }
            }
        }
#pragma unroll
        for (int g = 0; g < 4; ++g) {
#pragma unroll
            for (int e = 0; e < 8; ++e) { float a = acc[g][e]; a += __shfl_xor(a, 16); a += __shfl_xor(a, 32); acc[g][e] = a; }
            if (ksub == 0) {
                u32x4 wv4; wv4.x = pk2(acc[g][0], acc[g][1]); wv4.y = pk2(acc[g][2], acc[g][3]); wv4.z = pk2(acc[g][4], acc[g][5]); wv4.w = pk2(acc[g][6], acc[g][7]);
                *(u32x4*)(OB + (size_t)tok * 1024 + (n * 4 + g) * 128 + dc * 8) = wv4;
            }
        }
    }
}

DI void dsa_phase(const Params& P, unsigned char* lds, int G, int c) {
    unsigned char* ws = P.ws;
    const bf16_t* QI = (const bf16_t*)(ws + WS_QI); const bf16_t* KI = (const bf16_t*)(ws + WS_KI); const float* WI = (const float*)(ws + WS_WI);
    const bf16_t* QB = (const bf16_t*)(ws + WS_QB); const bf16_t* KB = (const bf16_t*)(ws + WS_KB); const bf16_t* VB = (const bf16_t*)(ws + WS_VB);
    bf16_t* OB = (bf16_t*)(ws + WS_H) + (size_t)TT * 1024;
    float* tabB = (float*)(lds + D_TABB);
    for (int i = threadIdx.x; i < 8 * 192; i += NTHREADS) { const int hd = i / 192, rel = i % 192 - 128; tabB[i] = P.in[7][t5_bucket(rel) * 16 + 8 + hd]; }
    __syncthreads();
    const int w = __builtin_amdgcn_readfirstlane(threadIdx.x >> 6);
    const int nprompt = TP / 4, nsample = TS / 4;
    const int nmine = (nprompt - c + G - 1) / G, ps0 = (c + G / 2) % G;
    for (int k = 0; k < nmine + ((ps0 < nsample) ? (nsample - ps0 + G - 1) / G : 0); ++k) {
        const int it = (k < nmine) ? (c + k * G) : (nprompt + ps0 + (k - nmine) * G);
        int tok0, qpos0, kbase, L;
        if (it < TP / 4) { tok0 = 4 * it; qpos0 = tok0; kbase = 0; L = 64 * ((qpos0 >> 6) + 1); }
        else { const int p = it - TP / 4, b = p >> 3, t0 = (p & 7) * 4; tok0 = TP + 32 * b + t0; qpos0 = PAST + t0; kbase = TP + b * NKS; L = NKS; }
#pragma unroll 1
        for (int pr = 0; pr < 2; ++pr) dsa_select(tok0 + 2 * (pr & 1), kbase, L, 2 * (pr & 1), QI, KI, WI, lds);
        const int nsel = L < 256 ? L : 256;
        const int q = w >> 1, n = w & 1;
        dsa_sparse(tok0 + q, qpos0 + q, kbase, nsel, n, (const int*)(lds + D_SEL) + q * 256, (float*)(lds + D_PN) + w * 1024, tabB, QB, KB, VB, OB);
        __syncthreads();
    }
}

__global__ void __launch_bounds__(NTHREADS, 2) mega_fwd(Params P) {
    extern __shared__ __attribute__((aligned(16))) unsigned char lds[];
    const int G = gridDim.x, c = blockIdx.x;
    const int lo = P.ph_lo, hi = P.ph_hi;
    unsigned char* ws = P.ws;
    PG8_LAS unsigned char* ring = (PG8_LAS unsigned char*)lds;
#define IN_(k) (lo <= (k) && (k) < hi)
    if (threadIdx.x < 2) ((volatile LAS unsigned*)((PG8_LAS unsigned char*)lds + (LDS_BYTES - 64)))[threadIdx.x] = 0u;
    __syncthreads();
    if (threadIdx.x == 0) (void)xb_add((unsigned*)(P.ws + WS_BAR) + XB_XCNT(xb_xcc_id()), 1u);
#define SEAM_(k) do { if (IN_(k) && IN_((k) + 1)) { if ((k) == 0) cg::this_grid().sync(); else { XcdBarrier xb_; xb_.bar = (unsigned*)(P.ws + WS_BAR); xb_.x = xb_xcc_id(); \
        xb_.st = (volatile LAS unsigned*)((PG8_LAS unsigned char*)lds + (LDS_BYTES - 64)); xcd_barrier(xb_); } } } while (0)
    if (IN_(0)) { for (int rep = 0; rep < (REP_PH == 0 ? 2 : 1); ++rep) { p0_prep(P, lds, G, c); __syncthreads(); } }
    SEAM_(0);
#ifndef SKIP_GEMM
    if (IN_(1)) for (int rep = 0; rep < (REP_PH == 1 ? 2 : 1); ++rep) {
        pg8::Gemm g{(const bf16_t*)(ws + WS_H), (const bf16_t*)(ws + WS_WT_IN), TT, NIN, DM, DM}; pg8::StaticOrder S; S.init(TT, NIN, G, c);
        EpiInProj E{P.out, ws, P.in[10], P.in[11], P.in[17], P.in[18], (float*)(lds + XCH_OFF)};
        pg8::gemm_phase<EpiInProj, pg8::StaticOrder, true, true>(ring, g, S, E);
    }
#endif
    SEAM_(1);
    if (IN_(2)) {
#ifndef SKIP_ATTN
        for (int rep = 0; rep < REP_ATTN; ++rep) { attn_a_phase(P, lds, G, c); __syncthreads(); }
#endif
#ifndef SKIP_DSA
        for (int rep = 0; rep < REP_DSA; ++rep) { dsa_phase(P, lds, G, c); }
#endif
    }
    SEAM_(2);
#ifndef SKIP_GEMM
    if (IN_(3)) for (int rep = 0; rep < (REP_PH == 3 ? 2 : 1); ++rep) {
        pg8::StaticOrder S; S.init(TT, DM, G, c);
        {
            pg8::Gemm g{(const bf16_t*)(ws + WS_H), (const bf16_t*)(ws + WS_WT_OA), TT, DM, 1024, 1024};
            EpiMerge<0> E{(const bf16_t*)(P.out + O_Y), (bf16_t*)(ws + WS_MERGED)};
            pg8::gemm_phase<EpiMerge<0>, pg8::StaticOrder, true, true>(ring, g, S, E);
        }
        __syncthreads();
        {
            pg8::Gemm g{(const bf16_t*)(ws + WS_H) + (size_t)TT * 1024, (const bf16_t*)(ws + WS_WT_OB), TT, DM, 1024, 1024};
            EpiMerge<1> E{(const bf16_t*)(P.out + O_Y), (bf16_t*)(ws + WS_MERGED)};
            pg8::gemm_phase<EpiMerge<1>, pg8::StaticOrder, true, true>(ring, g, S, E);
        }
    }
#endif
    SEAM_(3);
#ifndef SKIP_GEMM
    if (IN_(4)) for (int rep = 0; rep < (REP_PH == 4 ? 2 : 1); ++rep) {
        pg8::Gemm g{(const bf16_t*)(ws + WS_MERGED), (const bf16_t*)(ws + WS_WT_OUT), TT, DM, DM, DM}; pg8::StaticOrder S; S.init(TT, DM, G, c);
        EpiOut E{P.in[0], P.in[1], P.out + O_Y};
        pg8::gemm_phase<EpiOut, pg8::StaticOrder, true, true>(ring, g, S, E);
    }
#endif
    SEAM_(4);
    if (IN_(5)) { rmsnorm_rows(P.out + O_Y, P.out + O_Y + (size_t)TP * DM, P.in[22], (bf16_t*)(ws + WS_H), G, c); }
    SEAM_(5);
#ifndef SKIP_GEMM
    if (IN_(6)) for (int rep = 0; rep < (REP_PH == 6 ? 2 : 1); ++rep) {
        pg8::Gemm g{(const bf16_t*)(ws + WS_H), (const bf16_t*)(ws + WS_WT_FF1), TT, DFF, DM, DM}; pg8::StaticOrder S; S.init(TT, DFF, G, c);
        EpiFF1 E{(bf16_t*)(ws + WS_U)};
        pg8::gemm_phase<EpiFF1, pg8::StaticOrder, true, true>(ring, g, S, E);
    }
#endif
    SEAM_(6);
#ifndef SKIP_GEMM
    if (IN_(7)) {
        pg8::StaticOrder S; S.init(TT, DM, G, c);
        const int nunits = (TT / 256) * (DM / 256), rounds = nunits / G, left = nunits - rounds * G;
        {
            pg8::Gemm g{(const bf16_t*)(ws + WS_U), (const bf16_t*)(ws + WS_WT_FF2), TT, DM, DFF, DFF};
            OrderRounds SR{S, rounds};
            EpiFF2 E{P.out + O_Y};
            pg8::gemm_phase<EpiFF2, OrderRounds, true, true>(ring, g, SR, E);
        }
        for (int mi = c; mi < left * 16; mi += G) {
            const int r = mi % left, sl = mi / left;
            __syncthreads();
            pg8::Gemm g{(const bf16_t*)(ws + WS_U) + sl * 512, (const bf16_t*)(ws + WS_WT_FF2) + sl * 512, TT, DM, 512, DFF};
            OrderOne SO{S, rounds * G + r};
            EpiFF2Part E{(float*)(ws + WS_H) + (size_t)mi * 65536};
            pg8::gemm_phase<EpiFF2Part, OrderOne, true, true>(ring, g, SO, E);
        }
    }
    SEAM_(7);
    if (IN_(8)) {
        pg8::StaticOrder S; S.init(TT, DM, G, c);
        const int nunits = (TT / 256) * (DM / 256), rounds = nunits / G, left = nunits - rounds * G;
        const float* part = (const float*)(ws + WS_H);
        for (int t = c * NTHREADS + (int)threadIdx.x; t < left * 16384; t += G * NTHREADS) {
            const int r = t >> 14, e4 = t & 16383, rl = e4 >> 6, cl = (e4 & 63) * 4;
            pg8::Unit u; S.at((long)(rounds * G + r), u);
            f32x4 a = {0.f, 0.f, 0.f, 0.f};
#pragma unroll
            for (int sl = 0; sl < 16; ++sl) a += *(const f32x4*)(part + (size_t)(sl * left + r) * 65536 + rl * 256 + cl);
            float* yo = P.out + O_Y + (size_t)(u.pm * 256 + rl) * DM + u.pn * 256 + cl;
            *(f32x4*)yo = *(const f32x4*)yo + a;
        }
    }
#endif
}

extern "C" void kernel_launch(void* const* d_in, const int* in_sizes, int n_in, void* d_out, int out_size, void* d_ws, size_t ws_size, hipStream_t stream) {
    static int grid = 0;
    if (grid == 0) {
        if (n_in != 25 || (size_t)out_size != O_END || ws_size < WS_END) {
            fprintf(stderr, "kernel_launch: unexpected problem: n_in %d out_size %d (want %zu) ws %zu (want %zu)\n", n_in, out_size, (size_t)O_END, ws_size, (size_t)WS_END);
            grid = -1; return;
        }
        int dev = 0, cus = 0, per_cu = 0;
        hipGetDevice(&dev);
        hipDeviceGetAttribute(&cus, hipDeviceAttributeMultiprocessorCount, dev);
        hipFuncSetAttribute((const void*)mega_fwd, hipFuncAttributeMaxDynamicSharedMemorySize, LDS_BYTES);
        hipOccupancyMaxActiveBlocksPerMultiprocessor(&per_cu, (const void*)mega_fwd, NTHREADS, LDS_BYTES);
        if (per_cu < 1) { fprintf(stderr, "kernel_launch: occupancy query says %d blocks per CU\n", per_cu); per_cu = 1; }
        (void)hipGetLastError();
        grid = cus * per_cu;
    }
    if (grid < 0) return;
    if (hipMemsetAsync((char*)d_ws + WS_BAR, 0, WS_BAR_BYTES, stream) != hipSuccess) { fprintf(stderr, "kernel_launch: memset of the barrier words failed\n"); return; }
    Params p{};
    for (int i = 0; i < 25; ++i) p.in[i] = (const float*)d_in[i];
    p.out = (float*)d_out; p.ws = (unsigned char*)d_ws;
#if N_LAUNCH_MODE == 1
    p.ph_lo = 0; p.ph_hi = 9;
    void* args[] = {&p};
    hipError_t e = hipLaunchCooperativeKernel((const void*)mega_fwd, dim3(grid), dim3(NTHREADS), args, LDS_BYTES, stream);
    if (e != hipSuccess) fprintf(stderr, "cooperative launch failed: %s (grid %d)\n", hipGetErrorString(e), grid);
#else
    for (int ph = 0; ph < 9; ++ph) {
        p.ph_lo = ph; p.ph_hi = ph + 1;
        hipLaunchKernelGGL(mega_fwd, dim3(grid), dim3(NTHREADS), LDS_BYTES, stream, p);
    }
#endif
}
```

```cpp
#include <hip/hip_runtime.h>
#include <hip/hip_cooperative_groups.h>
#include <cstdio>
#include <cstdint>
namespace cg = cooperative_groups;
#ifndef N_LAUNCH_MODE
#define N_LAUNCH_MODE 1
#endif
#ifndef REP_ATTN
#define REP_ATTN 1
#endif
#ifndef REP_DSA
#define REP_DSA 1
#endif
#ifndef REP_IDX
#define REP_IDX 1
#endif
#ifndef REP_BIS
#define REP_BIS 1
#endif
#ifndef REP_SPARSE
#define REP_SPARSE 1
#endif
#ifndef REP_PH
#define REP_PH -1
#endif
#ifndef FORCE_SLOW
#define FORCE_SLOW 0
#endif
#ifndef XSYNC
#define XSYNC 0
#endif
namespace pg8 {
#define PG8_LAS __attribute__((address_space(3)))
typedef unsigned short bf16_t;
typedef short bf16x8 __attribute__((ext_vector_type(8)));
typedef float f32x4 __attribute__((ext_vector_type(4)));
typedef unsigned u32x4 __attribute__((ext_vector_type(4)));
constexpr int BM = 256, BK = 64, HALF = 128, HTB = HALF * BK * 2  , STAGE_BYTES = 8 * HTB, NXCD = 8, WGM = 8;

__host__ __device__ __forceinline__ int lds_byte(int r, int c) { const int st = (r >> 4) * 2 + (c >> 5), rr = r & 15, cc = c & 31, ob = rr * 64 + cc * 2; return st * 1024 + (ob ^ (((ob >> 9) & 1) << 5)); }
__host__ __device__ __forceinline__ void stage_rc(int b, int& R, int& C) { const int st = b / 1024, sb = b % 1024, swz = sb ^ (((sb >> 9) & 1) << 5); R = (st >> 1) * 16 + swz / 64; C = (st & 1) * 32 + (swz % 64) / 2; }
__host__ __device__ __forceinline__ int perm32(int rho) { const int n = rho >> 4, i = rho & 15; return 8 * (i >> 2) + 4 * n + (i & 3); }

struct Unit { int pm, pn; };
struct Gemm { const bf16_t* A; const bf16_t* Bt; int M, N, K, ld; };

struct StaticOrder {
    int nM, nN, nwg, G, c;
    __host__ __device__ void init(int M, int N, int G_, int c_) { nM = M / BM; nN = N / BM; nwg = nM * nN; G = G_; c = c_; }
    __host__ __device__ __forceinline__ bool next(int i, Unit& u) const { return at((long)i * G + c, u); }
    __host__ __device__ __forceinline__ bool at(const long L, Unit& u) const {
        if (L >= nwg) return false;
        int wgid = (int)L; { const int q = nwg / NXCD, r = nwg % NXCD, xcd = wgid % NXCD, off = wgid / NXCD; wgid = (xcd < r ? xcd * (q + 1) : r * (q + 1) + (xcd - r) * q) + off; }
        const int nig = WGM * nN, gid = wgid / nig, fm = gid * WGM, gsz = (nM - fm) < WGM ? (nM - fm) : WGM;
        u.pm = fm + ((wgid % nig) % gsz); u.pn = (wgid % nig) / gsz; return true;
    }
    __device__ __forceinline__ void a_ready(const Unit&) const {}
    __device__ __forceinline__ void done(const Unit&) const {}
};


template <class Epi, class Sched, bool ALIGN_EPI = false, bool SP2 = false>
__device__ __forceinline__ void gemm_phase(PG8_LAS unsigned char* lds, const Gemm g, const Sched& S, const Epi& E) {
    const int tid = threadIdx.x, wid = __builtin_amdgcn_readfirstlane(tid >> 6), lane = tid & 63, wr = wid >> 2, wc = wid & 3, fr = lane & 15, fq = lane >> 4;
    const int K = g.K, nt = K / BK, LD = g.ld;
    unsigned voffA[2], voffB[2];
#pragma unroll
    for (int i = 0; i < 2; ++i) { int R, C; stage_rc(tid * 16 + i * 8192, R, C); const int Rb = Epi::PERM ? ((R & ~31) + perm32(R & 31)) : R;
        voffA[i] = (unsigned)(R * LD + C) * 2u; voffB[i] = (unsigned)(Rb * LD + C) * 2u; }
    const size_t kstep = (size_t)(BK * 2);
    const size_t hstep = (size_t)HALF * LD * 2;
    const size_t tstep = 2 * hstep;
    const unsigned ldsw = (unsigned)wid * 1024u;
    const int aoff = lds_byte(wr * 64 + fr, fq * 8), boff = lds_byte(wc * 32 + fr, fq * 8);
#define PG8_SA(b, h) (((b) * 2 + (h)) * HTB)
#define PG8_SB(b, h) ((4 + (b) * 2 + (h)) * HTB)
#define PG8_STAGE(bufoff, gbase, voff) do { _Pragma("unroll") for (int _i = 0; _i < 2; ++_i) \
        __builtin_amdgcn_global_load_lds((const unsigned*)((const char*)(gbase) + (voff)[_i]), (PG8_LAS unsigned*)(lds + (bufoff) + ldsw + _i * 8192), 16, 0, 0); } while (0)
#define PG8_LDA(dst, b, h) do { _Pragma("unroll") for (int m = 0; m < 4; ++m) _Pragma("unroll") for (int k = 0; k < 2; ++k) dst[m][k] = *(const PG8_LAS bf16x8*)(lds + PG8_SA(b, h) + aoff + m * 2048 + k * 1024); } while (0)
#define PG8_LDB(dst, b, h) do { _Pragma("unroll") for (int n = 0; n < 2; ++n) _Pragma("unroll") for (int k = 0; k < 2; ++k) dst[n][k] = *(const PG8_LAS bf16x8*)(lds + PG8_SB(b, h) + boff + n * 2048 + k * 1024); } while (0)
#define PG8_MMA(ai, bj, At, Bt) do { __builtin_amdgcn_s_setprio(1); _Pragma("unroll") for (int m = 0; m < 4; ++m) _Pragma("unroll") for (int n = 0; n < 2; ++n) _Pragma("unroll") for (int k = 0; k < 2; ++k) \
        acc[ai][bj][m][n] = __builtin_amdgcn_mfma_f32_16x16x32_bf16(Bt[n][k], At[m][k], acc[ai][bj][m][n], 0, 0, 0); __builtin_amdgcn_s_setprio(0); } while (0)
#define PG8_WAIT_V(n) asm volatile("s_waitcnt vmcnt(" #n ")" ::: "memory")
#define PG8_WAIT_L(n) asm volatile("s_waitcnt lgkmcnt(" #n ")" ::: "memory")
#define PG8_BAR __builtin_amdgcn_s_barrier()
#define PG8_SCHED __builtin_amdgcn_sched_barrier(0)
    Unit cur, nxt; int ui = 0;
    if (!S.next(0, cur)) return;
    f32x4 acc[2][2][4][2];
#pragma unroll
    for (int a = 0; a < 2; ++a)
#pragma unroll
        for (int b = 0; b < 2; ++b)
#pragma unroll
            for (int m = 0; m < 4; ++m)
#pragma unroll
                for (int n = 0; n < 2; ++n) acc[a][b][m][n] = (f32x4){0.f, 0.f, 0.f, 0.f};
    bf16x8 At[4][2], B0[2][2], B1[2][2];
    const char* cA = (const char*)g.A + (size_t)cur.pm * tstep; const char* cB = (const char*)g.Bt + (size_t)cur.pn * tstep;
    S.a_ready(cur);
    if constexpr (SP2) {
        PG8_STAGE(PG8_SB(0, 0), cB, voffB); PG8_STAGE(PG8_SB(0, 1), cB + hstep, voffB); PG8_STAGE(PG8_SA(0, 0), cA, voffA); PG8_STAGE(PG8_SA(0, 1), cA + hstep, voffA);
        if (wr == 1) PG8_BAR;
        PG8_WAIT_V(2); PG8_BAR;
        PG8_STAGE(PG8_SB(1, 0), cB + kstep, voffB); PG8_STAGE(PG8_SA(1, 0), cA + kstep, voffA); PG8_STAGE(PG8_SB(1, 1), cB + hstep + kstep, voffB);
        PG8_WAIT_V(6); PG8_BAR;
    } else {
        PG8_STAGE(PG8_SB(0, 0), cB, voffB); PG8_STAGE(PG8_SA(0, 0), cA, voffA); PG8_STAGE(PG8_SB(0, 1), cB + hstep, voffB); PG8_STAGE(PG8_SA(0, 1), cA + hstep, voffA);
        if (wr == 1) PG8_BAR;
        PG8_WAIT_V(4); PG8_BAR;
        PG8_STAGE(PG8_SB(1, 0), cB + kstep, voffB); PG8_STAGE(PG8_SA(1, 0), cA + kstep, voffA); PG8_STAGE(PG8_SB(1, 1), cB + hstep + kstep, voffB);
        PG8_WAIT_V(6); PG8_BAR;
    }
    for (;;) {
        const bool has_next = S.next(ui + 1, nxt);
        const char* nA = has_next ? (const char*)g.A + (size_t)nxt.pm * tstep : cA; const char* nB = has_next ? (const char*)g.Bt + (size_t)nxt.pn * tstep : cB;
        for (int t = 0; t < nt; t += 2) {
            const bool last = (t == nt - 2);
            const char* a1 = cA + (size_t)(t + 1) * kstep;
            const char* a2 = last ? nA : cA + (size_t)(t + 2) * kstep; const char* b2 = last ? nB : cB + (size_t)(t + 2) * kstep;
            const char* a3 = a2 + kstep; const char* b3 = b2 + kstep;
            if (last && has_next) S.a_ready(nxt);
            if constexpr (SP2) {
            PG8_LDB(B0, 0, 0); PG8_LDB(B1, 0, 1); PG8_SCHED; PG8_LDA(At, 0, 0); PG8_STAGE(PG8_SA(1, 1), a1 + hstep, voffA);
            PG8_WAIT_V(8); PG8_WAIT_L(0); PG8_BAR; PG8_MMA(0, 0, At, B0); PG8_MMA(0, 1, At, B1); PG8_BAR; PG8_SCHED;
            PG8_LDA(At, 0, 1); PG8_STAGE(PG8_SB(0, 0), b2, voffB); PG8_STAGE(PG8_SB(0, 1), b2 + hstep, voffB); PG8_STAGE(PG8_SA(0, 0), a2, voffA);
            PG8_WAIT_V(8); PG8_WAIT_L(0); PG8_BAR; PG8_MMA(1, 0, At, B0); PG8_MMA(1, 1, At, B1); PG8_BAR; PG8_SCHED;
            PG8_LDB(B0, 1, 0); PG8_LDB(B1, 1, 1); PG8_SCHED; PG8_LDA(At, 1, 0); PG8_STAGE(PG8_SA(0, 1), a2 + hstep, voffA);
            PG8_WAIT_V(8); PG8_WAIT_L(0); PG8_BAR; PG8_MMA(0, 0, At, B0); PG8_MMA(0, 1, At, B1); PG8_BAR; PG8_SCHED;
            PG8_LDA(At, 1, 1); PG8_STAGE(PG8_SB(1, 0), b3, voffB); PG8_STAGE(PG8_SB(1, 1), b3 + hstep, voffB); PG8_STAGE(PG8_SA(1, 0), a3, voffA);
            PG8_WAIT_V(8); PG8_WAIT_L(0); PG8_BAR; PG8_MMA(1, 0, At, B0); PG8_MMA(1, 1, At, B1); PG8_BAR; PG8_SCHED;
            } else {
            PG8_LDB(B0, 0, 0); PG8_SCHED; PG8_LDA(At, 0, 0); PG8_STAGE(PG8_SA(1, 1), a1 + hstep, voffA);
            PG8_WAIT_L(8); PG8_BAR; PG8_WAIT_L(0); PG8_MMA(0, 0, At, B0); PG8_BAR; PG8_SCHED;
            PG8_LDB(B1, 0, 1); PG8_STAGE(PG8_SB(0, 0), b2, voffB);
            PG8_BAR; PG8_WAIT_L(0); PG8_MMA(0, 1, At, B1); PG8_BAR;
            PG8_LDA(At, 0, 1); PG8_STAGE(PG8_SA(0, 0), a2, voffA);
            PG8_BAR; PG8_WAIT_L(0); PG8_MMA(1, 0, At, B0); PG8_BAR; PG8_SCHED;
            PG8_STAGE(PG8_SB(0, 1), b2 + hstep, voffB);
            PG8_WAIT_V(6); PG8_BAR; PG8_MMA(1, 1, At, B1); PG8_BAR;
            PG8_LDB(B0, 1, 0); PG8_SCHED; PG8_LDA(At, 1, 0); PG8_STAGE(PG8_SA(0, 1), a2 + hstep, voffA);
            PG8_WAIT_L(8); PG8_BAR; PG8_WAIT_L(0); PG8_MMA(0, 0, At, B0); PG8_BAR; PG8_SCHED;
            PG8_LDB(B1, 1, 1); PG8_STAGE(PG8_SB(1, 0), b3, voffB);
            PG8_BAR; PG8_WAIT_L(0); PG8_MMA(0, 1, At, B1); PG8_BAR;
            PG8_LDA(At, 1, 1); PG8_STAGE(PG8_SA(1, 0), a3, voffA);
            PG8_BAR; PG8_WAIT_L(0); PG8_MMA(1, 0, At, B0); PG8_BAR; PG8_SCHED;
            PG8_STAGE(PG8_SB(1, 1), b3 + hstep, voffB);
            PG8_WAIT_V(6); PG8_BAR; PG8_MMA(1, 1, At, B1); PG8_BAR;
            }
        }
        if constexpr (ALIGN_EPI) { if (wr == 0) PG8_BAR; }
        if constexpr (!Epi::AFTER_DRAIN) { E(acc, cur, wr, wc, fr, fq); S.done(cur); }
        if (!has_next) break;
#pragma unroll
        for (int a = 0; a < 2; ++a)
#pragma unroll
            for (int b = 0; b < 2; ++b)
#pragma unroll
                for (int m = 0; m < 4; ++m)
#pragma unroll
                    for (int n = 0; n < 2; ++n) acc[a][b][m][n] = (f32x4){0.f, 0.f, 0.f, 0.f};
        cur = nxt; cA = nA; cB = nB; ++ui;
        if constexpr (ALIGN_EPI) { if (wr == 1) PG8_BAR; }
    }
    PG8_WAIT_V(0);
    if constexpr (!ALIGN_EPI) { if (wr == 0) PG8_BAR; }
    PG8_BAR;
    if constexpr (Epi::AFTER_DRAIN) { E.fused(acc, cur, wr, wc, fr, fq, lds, wid, lane); S.done(cur); }
#undef PG8_SA
#undef PG8_SB
#undef PG8_STAGE
#undef PG8_LDA
#undef PG8_LDB
#undef PG8_MMA
#undef PG8_WAIT_V
#undef PG8_WAIT_L
#undef PG8_BAR
#undef PG8_SCHED
}
}


#define DI __device__ __forceinline__
typedef unsigned short bf16_t;
typedef short bf16x8 __attribute__((ext_vector_type(8)));
typedef float f32x4 __attribute__((ext_vector_type(4)));
typedef float f32x16 __attribute__((ext_vector_type(16)));
typedef unsigned u32x4 __attribute__((ext_vector_type(4)));
typedef unsigned u32x2 __attribute__((ext_vector_type(2)));
typedef __bf16 bf16x2_t __attribute__((ext_vector_type(2)));
typedef float f32x2_t __attribute__((ext_vector_type(2)));
DI unsigned pk2(float a, float b) { f32x2_t v = {a, b}; bf16x2_t r = __builtin_convertvector(v, bf16x2_t); return __builtin_bit_cast(unsigned, r); }
DI float bflo(unsigned u) { return __uint_as_float(u << 16); }
DI float bfhi(unsigned u) { return __uint_as_float(u & 0xffff0000u); }
#define MFMA32(a, b, c) __builtin_amdgcn_mfma_f32_32x32x16_bf16((a), (b), (c), 0, 0, 0)
#define MFMA16(a, b, c) __builtin_amdgcn_mfma_f32_16x16x32_bf16((a), (b), (c), 0, 0, 0)

constexpr int TP = 16384, TS = 512, TT = TP + TS, DM = 2048, DFF = 8192;
constexpr int NIN = 9984;
constexpr int NB = 16, PAST = 1024, NKS = 1056;
constexpr int KVROWS = TP + NB * NKS;
constexpr float EPS = 1e-6f, LOG2E = 1.4426950408889634f;
constexpr int NTHREADS = 512;
constexpr int LDS_BYTES = 147456;
constexpr int XCH_OFF = 131072;

constexpr size_t al256(size_t x) { return (x + 255) & ~(size_t)255; }
constexpr size_t WS_WT_IN = 0;
constexpr size_t WS_WT_OA = WS_WT_IN + al256((size_t)NIN * DM * 2);
constexpr size_t WS_WT_OB = WS_WT_OA + al256((size_t)DM * 1024 * 2);
constexpr size_t WS_WT_OUT = WS_WT_OB + al256((size_t)DM * 1024 * 2);
constexpr size_t WS_WT_FF1 = WS_WT_OUT + al256((size_t)DM * DM * 2);
constexpr size_t WS_WT_FF2 = WS_WT_FF1 + al256((size_t)DFF * DM * 2);
constexpr size_t WS_H = WS_WT_FF2 + al256((size_t)DM * DFF * 2);
constexpr size_t WS_R = WS_H + al256((size_t)TT * DM * 2);
constexpr size_t WS_QA = WS_R;
constexpr size_t WS_QB = WS_QA + al256((size_t)TT * 1024 * 2);
constexpr size_t WS_QI = WS_QB + al256((size_t)TT * 1024 * 2);
constexpr size_t WS_KA = WS_QI + al256((size_t)TT * 1024 * 2);
constexpr size_t WS_VA = WS_KA + al256((size_t)KVROWS * 1024 * 2);
constexpr size_t WS_KB = WS_VA + al256((size_t)KVROWS * 1024 * 2);
constexpr size_t WS_VB = WS_KB + al256((size_t)KVROWS * 256 * 2);
constexpr size_t WS_KI = WS_VB + al256((size_t)KVROWS * 256 * 2);
constexpr size_t WS_WI = WS_KI + al256((size_t)KVROWS * 64 * 2);
constexpr size_t WS_REND = WS_WI + al256((size_t)TT * 16 * 4);
constexpr size_t WS_SELG = WS_REND;
constexpr size_t WS_SELG_END = WS_SELG + al256((size_t)TT * 256 * 4);
constexpr size_t WS_BAR = WS_SELG_END;
constexpr size_t WS_BAR_BYTES = 16384;
constexpr size_t WS_MERGED = WS_QA;
constexpr size_t WS_U = WS_R;
constexpr size_t WS_END = ((WS_BAR + WS_BAR_BYTES) > WS_U + (size_t)TT * DFF * 2) ? (WS_BAR + WS_BAR_BYTES) : (WS_U + al256((size_t)TT * DFF * 2));
static_assert(WS_QB + al256((size_t)TT * 1024 * 2) >= WS_MERGED + (size_t)TT * DM * 2, "merged overlay");

constexpr size_t O_Y = 0;
constexpr size_t O_PAK = O_Y + (size_t)TT * DM;
constexpr size_t O_PAV = O_PAK + (size_t)TP * 1024;
constexpr size_t O_PBK = O_PAV + (size_t)TP * 1024;
constexpr size_t O_PBV = O_PBK + (size_t)TP * 256;
constexpr size_t O_PKI = O_PBV + (size_t)TP * 256;
constexpr size_t O_SAK = O_PKI + (size_t)TP * 64;
constexpr size_t O_SAV = O_SAK + (size_t)TS * 1024;
constexpr size_t O_SBK = O_SAV + (size_t)TS * 1024;
constexpr size_t O_SBV = O_SBK + (size_t)TS * 256;
constexpr size_t O_SKI = O_SBV + (size_t)TS * 256;
constexpr size_t O_END = O_SKI + (size_t)TS * 64;

struct Params { const float* in[25]; float* out; unsigned char* ws; int ph_lo, ph_hi; };

DI int kvrow(int r) { if (r < TP) return r; const int s = r - TP; return TP + (s >> 5) * NKS + PAST + (s & 31); }

template <int MODE>
DI void tconv_tile(const float* __restrict__ src, int Ns, bf16_t* __restrict__ dst, int K, int kt, int nt, float* tile) {
    const int tid = threadIdx.x, k0 = kt * 64, n0 = nt * 64;
#pragma unroll
    for (int i = 0; i < 8; ++i) {
        const int k = i * 8 + (tid >> 6), n = tid & 63; int sc = n0 + n;
        if (MODE == 1) sc = (sc < 5712) ? sc : ((sc < 5888) ? -1 : sc - 176);
        tile[k * 65 + n] = (sc >= 0) ? src[(size_t)(k0 + k) * Ns + sc] : 0.f;
    }
    __syncthreads();
#pragma unroll
    for (int i = 0; i < 4; ++i) {
        const int n = i * 16 + (tid >> 5), kp = tid & 31;
        const float v0 = tile[(2 * kp) * 65 + n], v1 = tile[(2 * kp + 1) * 65 + n];
        *(unsigned*)(dst + (size_t)(n0 + n) * K + k0 + 2 * kp) = pk2(v0, v1);
    }
    __syncthreads();
}

DI float wave_sum(float v) {
#pragma unroll
    for (int o = 1; o < 64; o <<= 1) v += __shfl_xor(v, o);
    return v;
}

DI void rmsnorm_rows(const float* __restrict__ srcA, const float* __restrict__ srcB, const float* __restrict__ g, bf16_t* __restrict__ dst, int G, int c) {
    const int lane = threadIdx.x & 63, wave = __builtin_amdgcn_readfirstlane(threadIdx.x >> 6);
    for (int r = c * 8 + wave; r < TT; r += G * 8) {
        const float* s = (r < TP) ? srcA + (size_t)r * DM : srcB + (size_t)(r - TP) * DM;
        f32x4 v[8]; float ss = 0.f;
#pragma unroll
        for (int i = 0; i < 8; ++i) { v[i] = *(const f32x4*)(s + i * 256 + lane * 4); ss += v[i][0] * v[i][0] + v[i][1] * v[i][1] + v[i][2] * v[i][2] + v[i][3] * v[i][3]; }
        ss = wave_sum(ss);
        const float rs = rsqrtf(ss * (1.0f / DM) + EPS);
#pragma unroll
        for (int i = 0; i < 8; ++i) {
            const f32x4 gg = *(const f32x4*)(g + i * 256 + lane * 4);
            u32x2 w; w.x = pk2(v[i][0] * rs * gg[0], v[i][1] * rs * gg[1]); w.y = pk2(v[i][2] * rs * gg[2], v[i][3] * rs * gg[3]);
            *(u32x2*)(dst + (size_t)r * DM + i * 256 + lane * 4) = w;
        }
    }
}

DI void cache_conv(const float* __restrict__ src, bf16_t* __restrict__ dst, int W, int G, int c) {
    const size_t n8 = (size_t)NB * PAST * W / 8;
    for (size_t i = (size_t)c * NTHREADS + threadIdx.x; i < n8; i += (size_t)G * NTHREADS) {
        const size_t e = i * 8; const int row = (int)(e / W), col = (int)(e % W);
        const f32x4 a = *(const f32x4*)(src + e), b = *(const f32x4*)(src + e + 4);
        u32x4 w; w.x = pk2(a[0], a[1]); w.y = pk2(a[2], a[3]); w.z = pk2(b[0], b[1]); w.w = pk2(b[2], b[3]);
        const int drow = TP + (row >> 10) * NKS + (row & 1023);
        *(u32x4*)(dst + (size_t)drow * W + col) = w;
    }
}

DI void p0_prep(const Params& P, unsigned char* lds, int G, int c) {
    unsigned char* ws = P.ws;
    float* tile = (float*)lds;
    const int nt0 = 32 * 156, nt1 = 16 * 32, nt3 = 32 * 32, nt4 = 32 * 128, nt5 = 128 * 32;
    const int tot = nt0 + 2 * nt1 + nt3 + nt4 + nt5;
    for (int t = c; t < tot; t += G) {
        int u = t;
        if (u < nt0) { tconv_tile<1>(P.in[9], 9808, (bf16_t*)(ws + WS_WT_IN), DM, u & 31, u >> 5, tile); continue; }
        u -= nt0;
        if (u < nt1) { tconv_tile<0>(P.in[19], DM, (bf16_t*)(ws + WS_WT_OA), 1024, u & 15, u >> 4, tile); continue; }
        u -= nt1;
        if (u < nt1) { tconv_tile<0>(P.in[20], DM, (bf16_t*)(ws + WS_WT_OB), 1024, u & 15, u >> 4, tile); continue; }
        u -= nt1;
        if (u < nt3) { tconv_tile<0>(P.in[21], DM, (bf16_t*)(ws + WS_WT_OUT), DM, u & 31, u >> 5, tile); continue; }
        u -= nt3;
        if (u < nt4) { tconv_tile<0>(P.in[23], DFF, (bf16_t*)(ws + WS_WT_FF1), DM, u & 31, u >> 5, tile); continue; }
        u -= nt4;
        tconv_tile<0>(P.in[24], DM, (bf16_t*)(ws + WS_WT_FF2), DFF, u & 127, u >> 7, tile);
    }
    rmsnorm_rows(P.in[0], P.in[1], P.in[8], (bf16_t*)(ws + WS_H), G, c);
    cache_conv(P.in[2], (bf16_t*)(ws + WS_KA), 1024, G, c);
    cache_conv(P.in[3], (bf16_t*)(ws + WS_VA), 1024, G, c);
    cache_conv(P.in[4], (bf16_t*)(ws + WS_KB), 256, G, c);
    cache_conv(P.in[5], (bf16_t*)(ws + WS_VB), 256, G, c);
    cache_conv(P.in[6], (bf16_t*)(ws + WS_KI), 64, G, c);
}

struct OrderRounds { pg8::StaticOrder S; int rounds;
    DI bool next(int i, pg8::Unit& u) const { return i < rounds && S.next(i, u); }
    DI void a_ready(const pg8::Unit&) const {} DI void done(const pg8::Unit&) const {} };
struct OrderOne { pg8::StaticOrder S; int L;
    DI bool next(int i, pg8::Unit& u) const { if (i != 0) return false; return S.at((long)L, u); }
    DI void a_ready(const pg8::Unit&) const {} DI void done(const pg8::Unit&) const {} };

DI float sigmoidf_(float x) { return 1.0f / (1.0f + __expf(-x)); }

struct EpiInProj {
    static constexpr bool PERM = true, AFTER_DRAIN = false;
    float* out; unsigned char* ws; const float* g_qa; const float* g_ka; const float* g_qb; const float* g_kb; float* xch;
    DI void operator()(const f32x4 (&acc)[2][2][4][2], const pg8::Unit& u, int wr, int wc, int fr, int fq) const {
        const int pn = u.pn, pm = u.pm;
        const bool samp = (pm >= 64);
        int rowl0 = wr * 64 + fr, lc0 = wc * 32 + 8 * fq;
        asm volatile("" : "+v"(rowl0), "+v"(lc0));
        int norm = 0; const float* gain = nullptr; float post = 1.f; bool sig = false;
        float* f32p = nullptr; int f32ld = 0; bf16_t* b16p = nullptr; int b16ld = 0; bool kvm = false; int cb = 0;
        if (pn < 4)       { norm = 64; gain = g_qa; post = 0.125f; b16p = (bf16_t*)(ws + WS_QA); b16ld = 1024; cb = pn * 256; }
        else if (pn < 8)  { norm = 64; gain = g_ka; b16p = (bf16_t*)(ws + WS_KA); b16ld = 1024; kvm = true; cb = (pn - 4) * 256; f32p = out + (samp ? O_SAK : O_PAK); f32ld = 1024; }
        else if (pn < 12) { b16p = (bf16_t*)(ws + WS_VA); b16ld = 1024; kvm = true; cb = (pn - 8) * 256; f32p = out + (samp ? O_SAV : O_PAV); f32ld = 1024; }
        else if (pn < 16) { norm = 128; gain = g_qb; b16p = (bf16_t*)(ws + WS_QB); b16ld = 1024; cb = (pn - 12) * 256; }
        else if (pn == 16) { norm = 128; gain = g_kb; b16p = (bf16_t*)(ws + WS_KB); b16ld = 256; kvm = true; cb = 0; f32p = out + (samp ? O_SBK : O_PBK); f32ld = 256; }
        else if (pn == 17) { b16p = (bf16_t*)(ws + WS_VB); b16ld = 256; kvm = true; cb = 0; f32p = out + (samp ? O_SBV : O_PBV); f32ld = 256; }
        else if (pn < 22) { b16p = (bf16_t*)(ws + WS_QI); b16ld = 1024; cb = (pn - 18) * 256; }
        else if (pn == 22) {
#pragma unroll
            for (int ai = 0; ai < 2; ++ai)
#pragma unroll
                for (int m = 0; m < 4; ++m) {
                    const int r = pm * 256 + ai * 128 + m * 16 + rowl0;
                    const f32x4 v0 = acc[ai][0][m][0], v1 = acc[ai][0][m][1];
                    if (lc0 < 64) {
                        float* fo = out + (samp ? O_SKI + (size_t)(r - TP) * 64 : O_PKI + (size_t)r * 64) + lc0;
                        *(f32x4*)fo = v0; *(f32x4*)(fo + 4) = v1;
                        u32x4 w; w.x = pk2(v0[0], v0[1]); w.y = pk2(v0[2], v0[3]); w.z = pk2(v1[0], v1[1]); w.w = pk2(v1[2], v1[3]);
                        *(u32x4*)((bf16_t*)(ws + WS_KI) + (size_t)kvrow(r) * 64 + lc0) = w;
                    } else if (lc0 < 80) {
                        float* fo = (float*)(ws + WS_WI) + (size_t)r * 16 + (lc0 - 64);
                        *(f32x4*)fo = v0; *(f32x4*)(fo + 4) = v1;
                    }
                }
            return;
        }
        else if (pn < 31) { sig = true; b16p = (bf16_t*)(out + O_Y); b16ld = 4096; cb = (pn - 23) * 256; }
        else              { sig = true; b16p = (bf16_t*)(out + O_Y); b16ld = 4096; cb = 2048 + (pn - 31) * 256; }

        if (norm) {
#pragma unroll
            for (int ai = 0; ai < 2; ++ai)
#pragma unroll
                for (int m = 0; m < 4; ++m)
#pragma unroll
                    for (int bj = 0; bj < 2; ++bj) {
                        const f32x4 a = acc[ai][bj][m][0], b = acc[ai][bj][m][1];
                        float ss = a[0] * a[0] + a[1] * a[1] + a[2] * a[2] + a[3] * a[3] + b[0] * b[0] + b[1] * b[1] + b[2] * b[2] + b[3] * b[3];
                        ss += __shfl_xor(ss, 16); ss += __shfl_xor(ss, 32);
                        if (fq == 0) xch[(ai * 128 + m * 16 + rowl0) * 8 + bj * 4 + wc] = ss;
                    }
            __syncthreads();
        }
        f32x4 g0 = {1.f, 1.f, 1.f, 1.f}, g1 = {1.f, 1.f, 1.f, 1.f};
        if (norm) { g0 = *(const f32x4*)(gain + lc0); g1 = *(const f32x4*)(gain + lc0 + 4); }
#pragma unroll
        for (int ai = 0; ai < 2; ++ai)
#pragma unroll
            for (int m = 0; m < 4; ++m) {
                const int rl = ai * 128 + m * 16 + rowl0, r = pm * 256 + rl;
                const size_t brow = kvm ? (size_t)kvrow(r) : (size_t)r;
                const size_t frow = samp ? (size_t)(r - TP) : (size_t)r;
#pragma unroll
                for (int bj = 0; bj < 2; ++bj) {
                    f32x4 v0 = acc[ai][bj][m][0], v1 = acc[ai][bj][m][1];
                    if (norm) {
                        const f32x4 p4 = *(const f32x4*)(xch + rl * 8 + bj * 4);
                        float s;
                        if (norm == 64) s = (wc & 2) ? (p4[2] + p4[3]) : (p4[0] + p4[1]); else s = (p4[0] + p4[1]) + (p4[2] + p4[3]);
                        const float rs = rsqrtf(s * (norm == 64 ? (1.0f / 64.0f) : (1.0f / 128.0f)) + EPS);
                        v0 = v0 * rs * g0; v1 = v1 * rs * g1;
                    }
                    if (sig) { for (int e = 0; e < 4; ++e) { v0[e] = sigmoidf_(v0[e]); v1[e] = sigmoidf_(v1[e]); } }
                    const int col = cb + bj * 128 + lc0;
                    if (f32p) { float* fo = f32p + frow * f32ld + col; *(f32x4*)fo = v0; *(f32x4*)(fo + 4) = v1; }
                    v0 = v0 * post; v1 = v1 * post;
                    u32x4 w; w.x = pk2(v0[0], v0[1]); w.y = pk2(v0[2], v0[3]); w.z = pk2(v1[0], v1[1]); w.w = pk2(v1[2], v1[3]);
                    *(u32x4*)(b16p + brow * b16ld + col) = w;
                }
            }
    }
};

template <int PASS> struct EpiMerge {
    static constexpr bool PERM = true, AFTER_DRAIN = false;
    const bf16_t* gate; bf16_t* merged;
    DI void operator()(const f32x4 (&acc)[2][2][4][2], const pg8::Unit& u, int wr, int wc, int fr, int fq) const {
        const int rowl0 = wr * 64 + fr, lc0 = wc * 32 + 8 * fq;
#pragma unroll
        for (int ai = 0; ai < 2; ++ai)
#pragma unroll
            for (int m = 0; m < 4; ++m) {
                const size_t r = (size_t)u.pm * 256 + ai * 128 + m * 16 + rowl0;
#pragma unroll
                for (int bj = 0; bj < 2; ++bj) {
                    const int col = u.pn * 256 + bj * 128 + lc0;
                    const u32x4 gw = *(const u32x4*)(gate + r * 4096 + PASS * 2048 + col);
                    f32x4 v0 = acc[ai][bj][m][0], v1 = acc[ai][bj][m][1];
                    v0[0] *= bflo(gw.x); v0[1] *= bfhi(gw.x); v0[2] *= bflo(gw.y); v0[3] *= bfhi(gw.y);
                    v1[0] *= bflo(gw.z); v1[1] *= bfhi(gw.z); v1[2] *= bflo(gw.w); v1[3] *= bfhi(gw.w);
                    bf16_t* mp = merged + r * DM + col;
                    if (PASS == 1) {
                        const u32x4 t = *(const u32x4*)mp;
                        v0[0] += bflo(t.x); v0[1] += bfhi(t.x); v0[2] += bflo(t.y); v0[3] += bfhi(t.y);
                        v1[0] += bflo(t.z); v1[1] += bfhi(t.z); v1[2] += bflo(t.w); v1[3] += bfhi(t.w);
                    }
                    u32x4 w; w.x = pk2(v0[0], v0[1]); w.y = pk2(v0[2], v0[3]); w.z = pk2(v1[0], v1[1]); w.w = pk2(v1[2], v1[3]);
                    *(u32x4*)mp = w;
                }
            }
    }
};

struct EpiOut {
    static constexpr bool PERM = true, AFTER_DRAIN = false;
    const float* xp; const float* xs; float* y;
    DI void operator()(const f32x4 (&acc)[2][2][4][2], const pg8::Unit& u, int wr, int wc, int fr, int fq) const {
        const int rowl0 = wr * 64 + fr, lc0 = wc * 32 + 8 * fq;
#pragma unroll
        for (int ai = 0; ai < 2; ++ai)
#pragma unroll
            for (int m = 0; m < 4; ++m) {
                const int r = u.pm * 256 + ai * 128 + m * 16 + rowl0;
                const float* xr = (r < TP) ? xp + (size_t)r * DM : xs + (size_t)(r - TP) * DM;
#pragma unroll
                for (int bj = 0; bj < 2; ++bj) {
                    const int col = u.pn * 256 + bj * 128 + lc0;
                    const f32x4 a = *(const f32x4*)(xr + col), b = *(const f32x4*)(xr + col + 4);
                    float* yo = y + (size_t)r * DM + col;
                    *(f32x4*)yo = acc[ai][bj][m][0] + a; *(f32x4*)(yo + 4) = acc[ai][bj][m][1] + b;
                }
            }
    }
};

struct EpiFF1 {
    static constexpr bool PERM = true, AFTER_DRAIN = false;
    bf16_t* U;
    DI void operator()(const f32x4 (&acc)[2][2][4][2], const pg8::Unit& u, int wr, int wc, int fr, int fq) const {
        const int rowl0 = wr * 64 + fr, lc0 = wc * 32 + 8 * fq;
#pragma unroll
        for (int ai = 0; ai < 2; ++ai)
#pragma unroll
            for (int m = 0; m < 4; ++m) {
                const size_t r = (size_t)u.pm * 256 + ai * 128 + m * 16 + rowl0;
#pragma unroll
                for (int bj = 0; bj < 2; ++bj) {
                    const int col = u.pn * 256 + bj * 128 + lc0;
                    f32x4 v0 = acc[ai][bj][m][0], v1 = acc[ai][bj][m][1];
#pragma unroll
                    for (int e = 0; e < 4; ++e) { const float a = fmaxf(v0[e], 0.f), b = fmaxf(v1[e], 0.f); v0[e] = a * a; v1[e] = b * b; }
                    u32x4 w; w.x = pk2(v0[0], v0[1]); w.y = pk2(v0[2], v0[3]); w.z = pk2(v1[0], v1[1]); w.w = pk2(v1[2], v1[3]);
                    *(u32x4*)(U + r * DFF + col) = w;
                }
            }
    }
};

struct EpiFF2Part {
    static constexpr bool PERM = true, AFTER_DRAIN = false;
    float* part;
    DI void operator()(const f32x4 (&acc)[2][2][4][2], const pg8::Unit& u, int wr, int wc, int fr, int fq) const {
        const int rowl0 = wr * 64 + fr, lc0 = wc * 32 + 8 * fq;
#pragma unroll
        for (int ai = 0; ai < 2; ++ai)
#pragma unroll
            for (int m = 0; m < 4; ++m) {
                const int rl = ai * 128 + m * 16 + rowl0;
#pragma unroll
                for (int bj = 0; bj < 2; ++bj) {
                    float* po = part + rl * 256 + bj * 128 + lc0;
                    *(f32x4*)po = acc[ai][bj][m][0]; *(f32x4*)(po + 4) = acc[ai][bj][m][1];
                }
            }
    }
};

struct EpiFF2 {
    static constexpr bool PERM = true, AFTER_DRAIN = false;
    float* y;
    DI void operator()(const f32x4 (&acc)[2][2][4][2], const pg8::Unit& u, int wr, int wc, int fr, int fq) const {
        const int rowl0 = wr * 64 + fr, lc0 = wc * 32 + 8 * fq;
#pragma unroll
        for (int ai = 0; ai < 2; ++ai)
#pragma unroll
            for (int m = 0; m < 4; ++m) {
                const size_t r = (size_t)u.pm * 256 + ai * 128 + m * 16 + rowl0;
#pragma unroll
                for (int bj = 0; bj < 2; ++bj) {
                    const int col = u.pn * 256 + bj * 128 + lc0;
                    float* yo = y + r * DM + col;
                    const f32x4 a = *(const f32x4*)yo, b = *(const f32x4*)(yo + 4);
                    *(f32x4*)yo = acc[ai][bj][m][0] + a; *(f32x4*)(yo + 4) = acc[ai][bj][m][1] + b;
                }
            }
    }
};
#define LAS __attribute__((address_space(3)))
#define XB_TMO      128
#define XB_XCNT(j)  (256  + 64 * (j))
#define XB_XSUB(j)  (1280 + 64 * (j))
#define XB_XGEN(j)  (2304 + 64 * (j))
#define XB_TOP      3328
#define XB_TOPGEN   3392
#define XCD_BAR_WORDS 3456
#define XB_SPIN_CAP (1u << 18)

__device__ __forceinline__ unsigned xb_ld(unsigned* p)              { return __hip_atomic_load(p, __ATOMIC_RELAXED, __HIP_MEMORY_SCOPE_AGENT); }
__device__ __forceinline__ unsigned xb_add(unsigned* p, unsigned v) { return __hip_atomic_fetch_add(p, v, __ATOMIC_RELAXED, __HIP_MEMORY_SCOPE_AGENT); }
__device__ __forceinline__ unsigned xb_xcc_id() { return (unsigned)__builtin_amdgcn_s_getreg((3 << 11) | 20) & 0xFu; }
#define XB_SPIN(cond, bar) do { unsigned _sp = 0; while (cond) { __builtin_amdgcn_s_sleep(1); \
    if ((++_sp & 255u) == 0u) { if (xb_ld(&(bar)[XB_TMO])) break; if (_sp > XB_SPIN_CAP) { atomicAdd(&(bar)[XB_TMO], 1u); break; } } } } while (0)

struct XcdBarrier {
    unsigned* bar; unsigned x;
    volatile LAS unsigned* st;
};

__device__ __forceinline__ XcdBarrier xcd_barrier_post(unsigned* bar, volatile LAS unsigned* st) {
    XcdBarrier b; b.bar = bar; b.x = xb_xcc_id(); b.st = st;
    if (threadIdx.x == 0) (void)xb_add(&bar[XB_XCNT(b.x)], 1u);
    return b;
}
__device__ __forceinline__ void xcd_barrier_complete(unsigned* bar, unsigned x, unsigned& nloc, unsigned& nx) {
    const unsigned G = gridDim.x * gridDim.y * gridDim.z;
    unsigned sum, cnt, mine, sp = 0u;
    for (;;) {
        sum = 0u; cnt = 0u; mine = 0u;
#pragma unroll
        for (unsigned j = 0; j < 16; ++j) { const unsigned c = xb_ld(&bar[XB_XCNT(j)]); sum += c; cnt += (c > 0u) ? 1u : 0u; mine = (j == x) ? c : mine; }
        if (sum == G) break;
        __builtin_amdgcn_s_sleep(1);
        if ((++sp & 255u) == 0u) { if (xb_ld(&bar[XB_TMO])) break; if (sp > XB_SPIN_CAP) { atomicAdd(&bar[XB_TMO], 1u); break; } }
    }
    nloc = mine > 0u ? mine : 1u; nx = cnt > 0u ? cnt : 1u;
}

__device__ __forceinline__ void xcd_barrier(const XcdBarrier& b) {
    asm volatile("s_waitcnt vmcnt(0)" ::: "memory");
    __syncthreads();
    if (threadIdx.x == 0) {
        unsigned* bar = b.bar;
        __builtin_amdgcn_s_waitcnt(0);
        unsigned nloc = b.st[0], nx = b.st[1];
        if (nloc == 0u) { xcd_barrier_complete(bar, b.x, nloc, nx); b.st[0] = nloc; b.st[1] = nx; }
        const unsigned old = xb_add(&bar[XB_XSUB(b.x)], 1u);
        const unsigned gen = old / nloc;
        if (old + 1u == (gen + 1u) * nloc) {
            __builtin_amdgcn_fence(__ATOMIC_RELEASE, "agent");
            asm volatile("s_waitcnt vmcnt(0)" ::: "memory");
            const unsigned og = xb_add(&bar[XB_TOP], 1u);
            const unsigned tg = og / nx;
            if (og + 1u == (tg + 1u) * nx) xb_add(&bar[XB_TOPGEN], 1u);
            else XB_SPIN(xb_ld(&bar[XB_TOPGEN]) == tg, bar);
            __builtin_amdgcn_fence(__ATOMIC_ACQUIRE, "agent");
            xb_add(&bar[XB_XGEN(b.x)], 1u);
            asm volatile("s_waitcnt vmcnt(0)" ::: "memory");
        } else {
            XB_SPIN(xb_ld(&bar[XB_XGEN(b.x)]) == gen, bar);
            __builtin_amdgcn_fence(__ATOMIC_ACQUIRE, "agent");
            asm volatile("s_waitcnt vmcnt(0)" ::: "memory");
        }
    }
    __syncthreads();
}


DI int t5_bucket(int rel) {
    const int n = rel < 0 ? -rel : rel;
    int b;
    if (n < 8) b = n; else if (n < 12) b = 8; else if (n < 16) b = 9; else if (n < 23) b = 10; else if (n < 32) b = 11;
    else if (n < 46) b = 12; else if (n < 64) b = 13; else if (n < 91) b = 14; else b = 15;
    return b + (rel > 0 ? 16 : 0);
}

constexpr int KROW_B = 272;
constexpr int VROW_B = 136;
constexpr int QROW_B = 272;
constexpr int EXROW_B = 528;
constexpr int A_KS = 0;
constexpr int A_VT = A_KS + 2 * 64 * KROW_B;
constexpr int A_QS = A_VT + 2 * 128 * VROW_B;
constexpr int A_TAB = A_QS + 128 * QROW_B;
constexpr int A_END = A_TAB + 192 * 4;
constexpr int A_EX = 0;
static_assert(A_END <= LDS_BYTES && 128 * EXROW_B <= A_QS, "attention LDS");

struct AttnUnit { int h, qrow0, nq, qpos0, kbase, nkeys; };

#define GLBA_ __attribute__((address_space(1)))
DI void attn_a_unit(const AttnUnit U, const bf16_t* __restrict__ QA, const bf16_t* __restrict__ KA, const bf16_t* __restrict__ VA, bf16_t* __restrict__ OA,
                    const float* __restrict__ rel_bias, const float* __restrict__ subln_g, float lam, float mbound, unsigned char* lds) {
    int tid = threadIdx.x; asm volatile("" : "+v"(tid));
    const int lane = tid & 63, w = __builtin_amdgcn_readfirstlane(tid >> 6), hf = lane >> 5, l31 = lane & 31;
    const int c = w >> 2, wq = w & 3;
    const int h = U.h;
    int ntiles = (U.qpos0 + U.nq - 1) / 64 + 1; { const int nk = (U.nkeys + 63) / 64; ntiles = ntiles < nk ? ntiles : nk; }
    const bool active = (32 * wq < U.nq);
    const int qpos_w = U.qpos0 + 32 * wq;
    const int jmax_w = qpos_w >> 6;
    float* tab = (float*)(lds + A_TAB);
    if (tid < 192) { const int rel = tid - 128; tab[tid] = rel_bias[t5_bucket(rel) * 16 + h] - rel_bias[15 * 16 + h]; }
    {
#pragma unroll
        for (int i = 0; i < 4; ++i) {
            const int idx = i * 512 + tid, row = idx >> 4, seg = idx & 15;
            const int rr = row < U.nq ? row : U.nq - 1;
            const u32x4 v = *(const u32x4*)(QA + (size_t)(U.qrow0 + rr) * 1024 + h * 128 + seg * 8);
            *(u32x4*)(lds + A_QS + row * QROW_B + seg * 16) = v;
        }
    }
    const int k_key = tid >> 3, k_seg = tid & 7;
    const int v_clo = tid & 3, v_kp = ((tid >> 2) & 15) + 16 * ((tid >> 6) & 1), v_c = (tid >> 7) * 4 + v_clo;
    u32x4 kr0, kr1, vr0, vr1, kq0, kq1, vq0, vq1;
    const GLBA_ bf16_t* kgp = (const GLBA_ bf16_t*)(KA + (size_t)(U.kbase + k_key) * 1024 + h * 128 + k_seg * 16);
    const GLBA_ bf16_t* vgp = (const GLBA_ bf16_t*)(VA + (size_t)(U.kbase + 2 * v_kp) * 1024 + h * 128 + v_c * 8);
#define A_LOADK2(j, K0, K1) do { asm volatile("" : "+v"(kgp)); K0 = *(const GLBA_ u32x4*)kgp; K1 = *(const GLBA_ u32x4*)(kgp + 8); kgp += 64 * 1024; } while (0)
#define A_LOADV2(j, V0, V1) do { asm volatile("" : "+v"(vgp)); V0 = *(const GLBA_ u32x4*)vgp; V1 = *(const GLBA_ u32x4*)(vgp + 1024); vgp += 64 * 1024; } while (0)
#define A_STOREK2(b, K0, K1) do { \
        unsigned char* kd_ = lds + A_KS + (b) * 64 * KROW_B + k_key * KROW_B + k_seg * 32; \
        *(u32x4*)kd_ = K0; *(u32x4*)(kd_ + 16) = K1; } while (0)
#define A_STOREV2(b, V0, V1) do { \
        unsigned char* vd_ = lds + A_VT + (b) * 128 * VROW_B + (v_c * 8) * VROW_B + v_kp * 4; \
        *(unsigned*)(vd_ + 0 * VROW_B) = (V0.x & 0xffffu) | (V1.x << 16); *(unsigned*)(vd_ + 1 * VROW_B) = (V0.x >> 16) | (V1.x & 0xffff0000u); \
        *(unsigned*)(vd_ + 2 * VROW_B) = (V0.y & 0xffffu) | (V1.y << 16); *(unsigned*)(vd_ + 3 * VROW_B) = (V0.y >> 16) | (V1.y & 0xffff0000u); \
        *(unsigned*)(vd_ + 4 * VROW_B) = (V0.z & 0xffffu) | (V1.z << 16); *(unsigned*)(vd_ + 5 * VROW_B) = (V0.z >> 16) | (V1.z & 0xffff0000u); \
        *(unsigned*)(vd_ + 6 * VROW_B) = (V0.w & 0xffffu) | (V1.w << 16); *(unsigned*)(vd_ + 7 * VROW_B) = (V0.w >> 16) | (V1.w & 0xffff0000u); } while (0)

    A_LOADK2(0, kr0, kr1); A_STOREK2(0, kr0, kr1); A_LOADV2(0, vr0, vr1); A_STOREV2(0, vr0, vr1);
    A_LOADK2(1, kq0, kq1); A_LOADV2(1, vq0, vq1);
    __syncthreads();

    int oq_ = A_QS + (32 * wq + l31) * QROW_B + hf * 16 + c * 128; asm volatile("" : "+v"(oq_));
    const unsigned char* Qb0 = lds + oq_;
    int ov_ = A_VT + l31 * VROW_B + hf * 8; asm volatile("" : "+v"(ov_));
    int ok_ = A_KS + c * 128 + hf * 16 + l31 * KROW_B; asm volatile("" : "+v"(ok_));
    f32x16 O[4];
#pragma unroll
    for (int nt = 0; nt < 4; ++nt)
#pragma unroll
        for (int i = 0; i < 16; ++i) O[nt][i] = 0.f;
    float lrow = 0.f;
    const float mL = mbound * LOG2E;

    for (int j = 0; j < ntiles; ++j) {
        {
        const int buf = j & 1;
        const bool more = (j + 1 < ntiles);
        A_LOADK2(j + 2, kr0, kr1); A_LOADV2(j + 2, vr0, vr1);
        const bool doit = active && j <= jmax_w;
        bf16x8 pf[2][2];
        if (doit) {
            const unsigned char* Kb = lds + ok_ + buf * 64 * KROW_B;
            const bool near = (64 * j + 63 + 91 > qpos_w);
            const bool lastmask = (64 * j + 64 > U.nkeys);
            f32x16 s0, s1;
#pragma unroll
            for (int i = 0; i < 16; ++i) { s0[i] = 0.f; s1[i] = 0.f; }
#pragma unroll
            for (int ks = 0; ks < 4; ++ks) {
                const bf16x8 qf = *(const bf16x8*)(Qb0 + ks * 32);
                const bf16x8 k0 = *(const bf16x8*)(Kb + ks * 32);
                const bf16x8 k1 = *(const bf16x8*)(Kb + 32 * KROW_B + ks * 32);
                s0 = MFMA32(k0, qf, s0); s1 = MFMA32(k1, qf, s1);
            }
            if (near) {
                const int qp = qpos_w + l31;
#pragma unroll
                for (int i = 0; i < 16; ++i) {
                    const int key = 64 * j + (i & 3) + 8 * (i >> 2) + 4 * hf;
                    int r0 = key - qp, r1 = key + 32 - qp;
                    r0 = r0 < -128 ? -128 : r0; r1 = r1 < -128 ? -128 : r1;
                    s0[i] += tab[r0 + 128]; s1[i] += tab[r1 + 128];
                    if ((i & 3) == 3) __builtin_amdgcn_sched_barrier(0);
                }
            }
            if (lastmask) {
#pragma unroll
                for (int i = 0; i < 16; ++i) {
                    const int key = 64 * j + (i & 3) + 8 * (i >> 2) + 4 * hf;
                    if (key >= U.nkeys) s0[i] = -1e30f;
                    if (key + 32 >= U.nkeys) s1[i] = -1e30f;
                }
            }
            float rs = 0.f;
#pragma unroll
            for (int i = 0; i < 16; ++i) {
                s0[i] = __builtin_amdgcn_exp2f(__builtin_fmaf(s0[i], LOG2E, -mL));
                s1[i] = __builtin_amdgcn_exp2f(__builtin_fmaf(s1[i], LOG2E, -mL));
                rs += s0[i] + s1[i];
            }
            lrow += rs;
#pragma unroll
            for (int s = 0; s < 2; ++s) {
                u32x4 a, b;
                a.x = pk2(s0[8 * s + 0], s0[8 * s + 1]); a.y = pk2(s0[8 * s + 2], s0[8 * s + 3]); a.z = pk2(s0[8 * s + 4], s0[8 * s + 5]); a.w = pk2(s0[8 * s + 6], s0[8 * s + 7]);
                b.x = pk2(s1[8 * s + 0], s1[8 * s + 1]); b.y = pk2(s1[8 * s + 2], s1[8 * s + 3]); b.z = pk2(s1[8 * s + 4], s1[8 * s + 5]); b.w = pk2(s1[8 * s + 6], s1[8 * s + 7]);
                pf[0][s] = __builtin_bit_cast(bf16x8, a); pf[1][s] = __builtin_bit_cast(bf16x8, b);
            }
        }
        A_STOREK2(buf ^ 1, kq0, kq1);
        if (doit) {
#define A_VFRAG2(dst, h_) do { const unsigned char* vrow_ = Vb + ((h_) >> 1) * 32 * VROW_B; \
                _Pragma("unroll") for (int q_ = 0; q_ < 2; ++q_) { const int kb_ = (h_) & 1, s_ = q_; \
                    const u32x2 lo_ = *(const u32x2*)(vrow_ + (kb_ * 32 + 16 * s_) * 2); const u32x2 hi_ = *(const u32x2*)(vrow_ + (kb_ * 32 + 16 * s_ + 8) * 2); \
                    u32x4 vv_; vv_.x = lo_.x; vv_.y = lo_.y; vv_.z = hi_.x; vv_.w = hi_.y; dst[q_] = __builtin_bit_cast(bf16x8, vv_); } } while (0)
            const unsigned char* Vb = lds + ov_ + buf * 128 * VROW_B;
            bf16x8 va[2], vb[2];
            A_VFRAG2(va, 0); A_VFRAG2(vb, 1);
            __builtin_amdgcn_sched_barrier(0);
#pragma unroll
            for (int hh = 0; hh < 8; ++hh) {
                const int nt = hh >> 1, kb = hh & 1;
                if (kb == 0) { O[nt] = MFMA32(va[0], pf[kb][0], O[nt]); O[nt] = MFMA32(va[1], pf[kb][1], O[nt]); }
                else         { O[nt] = MFMA32(vb[0], pf[kb][0], O[nt]); O[nt] = MFMA32(vb[1], pf[kb][1], O[nt]); }
                __builtin_amdgcn_sched_barrier(0);
                if (hh + 2 < 8) { if (kb == 0) A_VFRAG2(va, hh + 2); else A_VFRAG2(vb, hh + 2); }
                __builtin_amdgcn_sched_barrier(0);
            }
#undef A_VFRAG2
        }
        A_STOREV2(buf ^ 1, vq0, vq1);
        __syncthreads();
            }
        ++j; if (j >= ntiles) break;
        {
        const int buf = j & 1;
        const bool more = (j + 1 < ntiles);
        A_LOADK2(j + 2, kq0, kq1); A_LOADV2(j + 2, vq0, vq1);
        const bool doit = active && j <= jmax_w;
        bf16x8 pf[2][2];
        if (doit) {
            const unsigned char* Kb = lds + ok_ + buf * 64 * KROW_B;
            const bool near = (64 * j + 63 + 91 > qpos_w);
            const bool lastmask = (64 * j + 64 > U.nkeys);
            f32x16 s0, s1;
#pragma unroll
            for (int i = 0; i < 16; ++i) { s0[i] = 0.f; s1[i] = 0.f; }
#pragma unroll
            for (int ks = 0; ks < 4; ++ks) {
                const bf16x8 qf = *(const bf16x8*)(Qb0 + ks * 32);
                const bf16x8 k0 = *(const bf16x8*)(Kb + ks * 32);
                const bf16x8 k1 = *(const bf16x8*)(Kb + 32 * KROW_B + ks * 32);
                s0 = MFMA32(k0, qf, s0); s1 = MFMA32(k1, qf, s1);
            }
            if (near) {
                const int qp = qpos_w + l31;
#pragma unroll
                for (int i = 0; i < 16; ++i) {
                    const int key = 64 * j + (i & 3) + 8 * (i >> 2) + 4 * hf;
                    int r0 = key - qp, r1 = key + 32 - qp;
                    r0 = r0 < -128 ? -128 : r0; r1 = r1 < -128 ? -128 : r1;
                    s0[i] += tab[r0 + 128]; s1[i] += tab[r1 + 128];
                    if ((i & 3) == 3) __builtin_amdgcn_sched_barrier(0);
                }
            }
            if (lastmask) {
#pragma unroll
                for (int i = 0; i < 16; ++i) {
                    const int key = 64 * j + (i & 3) + 8 * (i >> 2) + 4 * hf;
                    if (key >= U.nkeys) s0[i] = -1e30f;
                    if (key + 32 >= U.nkeys) s1[i] = -1e30f;
                }
            }
            float rs = 0.f;
#pragma unroll
            for (int i = 0; i < 16; ++i) {
                s0[i] = __builtin_amdgcn_exp2f(__builtin_fmaf(s0[i], LOG2E, -mL));
                s1[i] = __builtin_amdgcn_exp2f(__builtin_fmaf(s1[i], LOG2E, -mL));
                rs += s0[i] + s1[i];
            }
            lrow += rs;
#pragma unroll
            for (int s = 0; s < 2; ++s) {
                u32x4 a, b;
                a.x = pk2(s0[8 * s + 0], s0[8 * s + 1]); a.y = pk2(s0[8 * s + 2], s0[8 * s + 3]); a.z = pk2(s0[8 * s + 4], s0[8 * s + 5]); a.w = pk2(s0[8 * s + 6], s0[8 * s + 7]);
                b.x = pk2(s1[8 * s + 0], s1[8 * s + 1]); b.y = pk2(s1[8 * s + 2], s1[8 * s + 3]); b.z = pk2(s1[8 * s + 4], s1[8 * s + 5]); b.w = pk2(s1[8 * s + 6], s1[8 * s + 7]);
                pf[0][s] = __builtin_bit_cast(bf16x8, a); pf[1][s] = __builtin_bit_cast(bf16x8, b);
            }
        }
        A_STOREK2(buf ^ 1, kr0, kr1);
        if (doit) {
#define A_VFRAG2(dst, h_) do { const unsigned char* vrow_ = Vb + ((h_) >> 1) * 32 * VROW_B; \
                _Pragma("unroll") for (int q_ = 0; q_ < 2; ++q_) { const int kb_ = (h_) & 1, s_ = q_; \
                    const u32x2 lo_ = *(const u32x2*)(vrow_ + (kb_ * 32 + 16 * s_) * 2); const u32x2 hi_ = *(const u32x2*)(vrow_ + (kb_ * 32 + 16 * s_ + 8) * 2); \
                    u32x4 vv_; vv_.x = lo_.x; vv_.y = lo_.y; vv_.z = hi_.x; vv_.w = hi_.y; dst[q_] = __builtin_bit_cast(bf16x8, vv_); } } while (0)
            const unsigned char* Vb = lds + ov_ + buf * 128 * VROW_B;
            bf16x8 va[2], vb[2];
            A_VFRAG2(va, 0); A_VFRAG2(vb, 1);
            __builtin_amdgcn_sched_barrier(0);
#pragma unroll
            for (int hh = 0; hh < 8; ++hh) {
                const int nt = hh >> 1, kb = hh & 1;
                if (kb == 0) { O[nt] = MFMA32(va[0], pf[kb][0], O[nt]); O[nt] = MFMA32(va[1], pf[kb][1], O[nt]); }
                else         { O[nt] = MFMA32(vb[0], pf[kb][0], O[nt]); O[nt] = MFMA32(vb[1], pf[kb][1], O[nt]); }
                __builtin_amdgcn_sched_barrier(0);
                if (hh + 2 < 8) { if (kb == 0) A_VFRAG2(va, hh + 2); else A_VFRAG2(vb, hh + 2); }
                __builtin_amdgcn_sched_barrier(0);
            }
#undef A_VFRAG2
        }
        A_STOREV2(buf ^ 1, vr0, vr1);
        __syncthreads();
            }
    }
#undef A_LOADK2
#undef A_LOADV2
#undef A_STOREK2
#undef A_STOREV2
    const float ltot = lrow + __shfl_xor(lrow, 32);
    const float sc = (c == 0 ? 1.0f : lam) / ltot;
    unsigned char* exrow = lds + A_EX + (32 * wq + l31) * EXROW_B;
    if (active && c == 1) {
#pragma unroll
        for (int nt = 0; nt < 4; ++nt)
#pragma unroll
            for (int a = 0; a < 4; ++a) {
                f32x4 v = {O[nt][4 * a] * sc, O[nt][4 * a + 1] * sc, O[nt][4 * a + 2] * sc, O[nt][4 * a + 3] * sc};
                *(f32x4*)(exrow + (nt * 32 + 8 * a + 4 * hf) * 4) = v;
            }
    }
    __syncthreads();
    if (active && c == 0) {
        float ss = 0.f;
#pragma unroll
        for (int nt = 0; nt < 4; ++nt)
#pragma unroll
            for (int a = 0; a < 4; ++a) {
                const f32x4 v = *(const f32x4*)(exrow + (nt * 32 + 8 * a + 4 * hf) * 4);
#pragma unroll
                for (int e = 0; e < 4; ++e) { const float o = O[nt][4 * a + e] * sc - v[e]; O[nt][4 * a + e] = o; ss += o * o; }
            }
        ss += __shfl_xor(ss, 32);
        const float rs = rsqrtf(ss * (1.0f / 128.0f) + EPS) * 0.8f;
        bf16_t* orow = OA + (size_t)(U.qrow0 + 32 * wq + l31) * 1024 + h * 128;
#pragma unroll
        for (int nt = 0; nt < 4; ++nt)
#pragma unroll
            for (int a = 0; a < 4; ++a) {
                const int dv = nt * 32 + 8 * a + 4 * hf;
                const f32x4 g = *(const f32x4*)(subln_g + dv);
                u32x2 wv; wv.x = pk2(O[nt][4 * a + 0] * rs * g[0], O[nt][4 * a + 1] * rs * g[1]); wv.y = pk2(O[nt][4 * a + 2] * rs * g[2], O[nt][4 * a + 3] * rs * g[3]);
                *(u32x2*)(orow + dv) = wv;
            }
    }
    __syncthreads();
}

DI void attn_a_phase(const Params& P, unsigned char* lds, int G, int c) {
    unsigned char* ws = P.ws;
    const bf16_t* QA = (const bf16_t*)(ws + WS_QA); const bf16_t* KA = (const bf16_t*)(ws + WS_KA); const bf16_t* VA = (const bf16_t*)(ws + WS_VA);
    bf16_t* OA = (bf16_t*)(ws + WS_H);
    float lam;
    {
        int lane = threadIdx.x & 63; asm volatile("" : "+v"(lane));
        const float a = wave_sum(P.in[12][lane] * P.in[13][lane]), b = wave_sum(P.in[14][lane] * P.in[15][lane]);
        lam = __expf(a) - __expf(b) + 0.2f;
    }
    float mbound;
    {
        int lane = threadIdx.x & 63; asm volatile("" : "+v"(lane));
        float gq = fmaxf(fabsf(P.in[10][lane]), fabsf(P.in[10][lane + 64])), gk = fmaxf(fabsf(P.in[11][lane]), fabsf(P.in[11][lane + 64]));
        float bm = 0.f;
        for (int i = lane; i < 32 * 8; i += 64) { const int b = i >> 3, h = i & 7; bm = fmaxf(bm, fabsf(P.in[7][b * 16 + h] - P.in[7][15 * 16 + h])); }
#pragma unroll
        for (int o = 1; o < 64; o <<= 1) { gq = fmaxf(gq, __shfl_xor(gq, o)); gk = fmaxf(gk, __shfl_xor(gk, o)); bm = fmaxf(bm, __shfl_xor(bm, o)); }
        mbound = 8.0f * gq * gk + bm;
    }
    for (int k = c; k < 512; k += G) {
#pragma unroll 1
        for (int half = 0; half < 2; ++half) {
            const int h = k & 7, ii = k >> 3;
            const int i = half ? 127 - ii : ii;
            AttnUnit u{h, 128 * i, 128, 128 * i, 0, TP};
            attn_a_unit(u, QA, KA, VA, OA, P.in[7], P.in[16], lam, mbound, lds);
        }
    }
    for (int su = c; su < NB * 8; su += G) {
        const int h = su & 7, b = su >> 3;
        AttnUnit u{h, TP + 32 * b, 32, PAST, TP + b * NKS, NKS};
        attn_a_unit(u, QA, KA, VA, OA, P.in[7], P.in[16], lam, mbound, lds);
    }
}

constexpr int D_TABB = 0;
constexpr int D_CNT = D_TABB + 8 * 192 * 4;
constexpr int D_WTOT = D_CNT + 2 * 8 * 2 * 4;
constexpr int D_SEL = D_WTOT + 8 * 2 * 4 + 64;
constexpr int D_KST = D_SEL + 4 * 256 * 4;
constexpr int KST_BYTES = 256 * 128;
constexpr int DCAP = 2048;
constexpr int D_CU = D_KST;
constexpr int D_CK = D_CU + 2 * DCAP * 4;
constexpr int D_PN = D_KST + KST_BYTES;
constexpr int D_END = D_KST + 4 * KST_BYTES;
static_assert(D_END <= LDS_BYTES && D_CK + 2 * DCAP * 2 <= D_END, "dsa LDS");

DI void lds_barrier() { asm volatile("s_waitcnt lgkmcnt(0)" ::: "memory"); __builtin_amdgcn_s_barrier(); asm volatile("" ::: "memory"); }
DI unsigned f2sort(float f) { const unsigned u = __float_as_uint(f); return (u & 0x80000000u) ? ~u : (u | 0x80000000u); }
#define NEGKEY 0x007fffffu

DI void dsa_select(int tok0, int kbase, int L, int slot, const bf16_t* __restrict__ QI, const bf16_t* __restrict__ KI, const float* __restrict__ WI, unsigned char* lds) {
    int tid = threadIdx.x; asm volatile("" : "+v"(tid)); int lane = tid & 63;
    const int w = __builtin_amdgcn_readfirstlane(tid >> 6), hf = lane >> 5, l31 = lane & 31;
    const int NT = L >> 5;
    int* cntx = (int*)(lds + D_CNT); int* wtot = (int*)(lds + D_WTOT); int* sel = (int*)(lds + D_SEL);
    unsigned u[64];
    {
        const int r = l31, rq = (r >> 2) & 1, rh = (r >> 3) * 4 + (r & 3);
        bf16x8 qf[4];
#pragma unroll
        for (int ks = 0; ks < 4; ++ks) qf[ks] = *(const bf16x8*)(QI + (size_t)(tok0 + rq) * 1024 + rh * 64 + ks * 16 + hf * 8);
        float wv[16];
#pragma unroll
        for (int i = 0; i < 4; ++i) { const f32x4 t = *(const f32x4*)(WI + (size_t)(tok0 + hf) * 16 + 4 * i); wv[4 * i] = t[0]; wv[4 * i + 1] = t[1]; wv[4 * i + 2] = t[2]; wv[4 * i + 3] = t[3]; }
        int nstage = (NT + 7) >> 3;
        const int krow_ = lane >> 3, x0_ = (lane & 7) ^ (lane >> 4), x1_ = (lane & 7) ^ (4 + (lane >> 4));
        const char* gsrc = (const char*)(KI + (size_t)kbase * 64) + (size_t)(w * 32 + krow_) * 128;
        const int go0 = x0_ * 16, go1 = 8 * 128 + x1_ * 16, go2 = 16 * 128 + x0_ * 16, go3 = 24 * 128 + x1_ * 16;
        PG8_LAS unsigned char* lds3 = (PG8_LAS unsigned char*)lds;
        const int ldst = D_KST + w * 4096;
        const int xr_ = (l31 >> 1) & 7;
        const unsigned char* lrd = lds + D_KST + (w * 32 + l31) * 128;
        const int ro0 = ((0 + hf) ^ xr_) * 16, ro1 = ((2 + hf) ^ xr_) * 16, ro2 = ((4 + hf) ^ xr_) * 16, ro3 = ((6 + hf) ^ xr_) * 16;
#define D_DMA(bi) do { asm volatile("" : "+v"(gsrc)); \
        __builtin_amdgcn_global_load_lds((const unsigned*)(gsrc + go0), (PG8_LAS unsigned*)(lds3 + ldst + (bi) * KST_BYTES), 16, 0, 0); \
        __builtin_amdgcn_global_load_lds((const unsigned*)(gsrc + go1), (PG8_LAS unsigned*)(lds3 + ldst + (bi) * KST_BYTES + 1024), 16, 0, 0); \
        __builtin_amdgcn_global_load_lds((const unsigned*)(gsrc + go2), (PG8_LAS unsigned*)(lds3 + ldst + (bi) * KST_BYTES + 2048), 16, 0, 0); \
        __builtin_amdgcn_global_load_lds((const unsigned*)(gsrc + go3), (PG8_LAS unsigned*)(lds3 + ldst + (bi) * KST_BYTES + 3072), 16, 0, 0); \
        gsrc += KST_BYTES; } while (0)
        D_DMA(0); D_DMA(1);
        asm volatile("s_waitcnt vmcnt(0)" ::: "memory"); __builtin_amdgcn_s_barrier(); asm volatile("" ::: "memory");
#pragma unroll
        for (int g = 0; g < 8; ++g) {
            asm volatile("" : "+s"(nstage));
            if (nstage > 8 * g) {
#pragma unroll
                for (int e = 0; e < 4; ++e) {
                    const int sa = g * 8 + 2 * e, sb = sa + 1;
                    const int boa = (sa & 3) * KST_BYTES, bob = (sb & 3) * KST_BYTES;
                    D_DMA((sa + 2) & 3); D_DMA((sb + 2) & 3);
                    f32x16 da, db;
#pragma unroll
                    for (int i = 0; i < 16; ++i) { da[i] = 0.f; db[i] = 0.f; }
                    { const bf16x8 a0 = *(const bf16x8*)(lrd + boa + ro0), a1 = *(const bf16x8*)(lrd + boa + ro1), a2 = *(const bf16x8*)(lrd + boa + ro2), a3 = *(const bf16x8*)(lrd + boa + ro3);
                      const bf16x8 b0 = *(const bf16x8*)(lrd + bob + ro0), b1 = *(const bf16x8*)(lrd + bob + ro1), b2 = *(const bf16x8*)(lrd + bob + ro2), b3 = *(const bf16x8*)(lrd + bob + ro3);
                      da = MFMA32(qf[0], a0, da); db = MFMA32(qf[0], b0, db); da = MFMA32(qf[1], a1, da); db = MFMA32(qf[1], b1, db);
                      da = MFMA32(qf[2], a2, da); db = MFMA32(qf[2], b2, db); da = MFMA32(qf[3], a3, da); db = MFMA32(qf[3], b3, db); }
                    float sa0 = 0.f, sa1 = 0.f, sb0 = 0.f, sb1 = 0.f;
#pragma unroll
                    for (int i = 0; i < 8; ++i) {
                        sa0 = __builtin_fmaf(wv[2 * i], __builtin_amdgcn_fmed3f(da[2 * i], 0.f, __builtin_inff()), sa0); sa1 = __builtin_fmaf(wv[2 * i + 1], __builtin_amdgcn_fmed3f(da[2 * i + 1], 0.f, __builtin_inff()), sa1);
                        sb0 = __builtin_fmaf(wv[2 * i], __builtin_amdgcn_fmed3f(db[2 * i], 0.f, __builtin_inff()), sb0); sb1 = __builtin_fmaf(wv[2 * i + 1], __builtin_amdgcn_fmed3f(db[2 * i + 1], 0.f, __builtin_inff()), sb1);
                    }
                    u[sa] = (sa * 8 + w < NT) ? f2sort(sa0 + sa1) : NEGKEY;
                    u[sb] = (sb * 8 + w < NT) ? f2sort(sb0 + sb1) : NEGKEY;
                    asm volatile("s_waitcnt vmcnt(0)\n\ts_waitcnt lgkmcnt(0)" ::: "memory"); __builtin_amdgcn_s_barrier(); asm volatile("" ::: "memory");
                }
            } else {
#pragma unroll
                for (int e = 0; e < 8; ++e) u[g * 8 + e] = NEGKEY;
            }
        }
#undef D_DMA
    }
    const int nsel = L < 256 ? L : 256;
    unsigned* candU = (unsigned*)(lds + D_CU); unsigned short* candK = (unsigned short*)(lds + D_CK);
    bool fast = false;
    unsigned LB = 0u; int cbase = 0, cexcl = 0, ctot0 = 0, ctot1 = 0;
    if (L > 256) {
        unsigned m1 = u[0], m2 = 0u;
#pragma unroll
        for (int i = 1; i < 64; ++i) { const unsigned lo_ = m1 < u[i] ? m1 : u[i]; m2 = m2 > lo_ ? m2 : lo_; m1 = m1 > u[i] ? m1 : u[i]; }
        const unsigned p1 = (unsigned)__shfl_xor((int)m1, 1), p2 = (unsigned)__shfl_xor((int)m2, 1);
        const unsigned mx = m1 > p1 ? m1 : p1;
        const unsigned lo1 = m1 < p1 ? m1 : p1, hi2 = m2 > p2 ? m2 : p2;
        unsigned mn = lo1 > hi2 ? lo1 : hi2;
#pragma unroll
        for (int o = 1; o < 32; o <<= 1) { const unsigned t = (unsigned)__shfl_xor((int)mn, o); mn = mn < t ? mn : t; }
        unsigned mxx = mx;
#pragma unroll
        for (int o = 1; o < 32; o <<= 1) { const unsigned t = (unsigned)__shfl_xor((int)mxx, o); mxx = mxx > t ? mxx : t; }
        if (l31 == 0) { cntx[w * 2 + hf] = (int)mn; cntx[16 + w * 2 + hf] = (int)mxx; }
        __syncthreads();
        LB = (unsigned)cntx[hf];
#pragma unroll
        for (int ww = 1; ww < 8; ++ww) { const unsigned t = (unsigned)cntx[ww * 2 + hf]; LB = LB < t ? LB : t; }
        int cc = 0;
#pragma unroll
        for (int i = 0; i < 64; ++i) cc += (u[i] >= LB) ? 1 : 0;
        int incl = cc;
#pragma unroll
        for (int o = 1; o < 32; o <<= 1) { const int t = __shfl_up(incl, o, 32); if (l31 >= o) incl += t; }
        if (l31 == 31) wtot[w * 2 + hf] = incl;
        __syncthreads();
#pragma unroll
        for (int ww = 0; ww < 8; ++ww) { const int t0 = wtot[ww * 2], t1 = wtot[ww * 2 + 1]; ctot0 += t0; ctot1 += t1; if (ww < w) cbase += hf ? t1 : t0; }
        cexcl = incl - cc;
        fast = (ctot0 <= DCAP) && (ctot1 <= DCAP);
    }
    if (fast) {
        {
            int pos = cbase + cexcl;
            asm volatile("" : "+v"(LB));
#pragma unroll
            for (int i = 0; i < 64; ++i) if (u[i] >= LB) { candU[hf * DCAP + pos] = u[i]; candK[hf * DCAP + pos] = (unsigned short)((i * 8 + w) * 32 + l31); ++pos; }
        }
        __syncthreads();
        const int qq = w >> 2, ts = tid & 255, ntot = qq ? ctot1 : ctot0;
        unsigned cu[8];
#pragma unroll
        for (int k = 0; k < 8; ++k) { const int idx = ts + 256 * k; cu[k] = idx < ntot ? candU[qq * DCAP + idx] : 0u; }
        unsigned* tq = (unsigned*)(lds + D_WTOT) + 16;
        if (w < 2) {
            const int nt_ = w ? ctot1 : ctot0;
            unsigned lbq = (unsigned)cntx[w], mxq = (unsigned)cntx[16 + w];
#pragma unroll
            for (int ww = 1; ww < 8; ++ww) { const unsigned a_ = (unsigned)cntx[ww * 2 + w], b_ = (unsigned)cntx[16 + ww * 2 + w]; lbq = lbq < a_ ? lbq : a_; mxq = mxq > b_ ? mxq : b_; }
            lbq = __builtin_amdgcn_readfirstlane(lbq); mxq = __builtin_amdgcn_readfirstlane(mxq);
            unsigned ce[32];
#pragma unroll
            for (int k = 0; k < 32; ++k) { const int idx = lane + 64 * k; ce[k] = idx < nt_ ? (candU[w * DCAP + idx] - lbq) : 0u; }
            const unsigned span = mxq - lbq;
            const int nb = span ? 32 - __builtin_clz(span) : 0;
            unsigned Tw = 0u;
            int kmax = (nt_ + 63) >> 6;
            for (int bit = nb - 1; bit >= 0; --bit) {
                const unsigned cand = Tw | (1u << bit);
                int cl = 0;
#pragma unroll
                for (int g = 0; g < 4; ++g) {
                    if (kmax > 8 * g) {
#pragma unroll
                        for (int e = 0; e < 8; ++e) cl += (ce[g * 8 + e] >= cand) ? 1 : 0;
                    }
                }
                int n = 0;
#pragma unroll
                for (int b_ = 0; b_ < 6; ++b_) n += __builtin_popcountll(__builtin_amdgcn_ballot_w64(((cl >> b_) & 1) != 0)) << b_;
                if (n == 256) { Tw = cand - 1u; break; }
                if (n > 256) Tw = cand;
            }
            Tw += lbq;
            if (lane == 0) tq[w] = Tw;
        }
        __syncthreads();
        unsigned T = tq[qq];
        int c2 = 0;
#pragma unroll
        for (int k = 0; k < 8; ++k) c2 += (cu[k] > T ? 1 : 0) + (cu[k] == T ? 65536 : 0);
        int incl = c2;
#pragma unroll
        for (int o = 1; o < 64; o <<= 1) { const int t = __shfl_up(incl, o, 64); if (lane >= o) incl += t; }
        if (lane == 63) wtot[w] = incl;
        __syncthreads();
        int base = 0, total = 0;
#pragma unroll
        for (int ww = 0; ww < 4; ++ww) { const int t = wtot[qq * 4 + ww]; total += t; if (ww < (w & 3)) base += t; }
        const int excl = incl - c2;
        int pos_gt = (base & 0xffff) + (excl & 0xffff);
        int pos_eq = (total & 0xffff) + (base >> 16) + (excl >> 16);
        int* sl = sel + (slot + qq) * 256;
        asm volatile("" : "+v"(T));
#pragma unroll
        for (int k = 0; k < 8; ++k) {
            const int idx = ts + 256 * k;
            if (cu[k] > T) { if (pos_gt < 256) sl[pos_gt] = candK[qq * DCAP + idx]; ++pos_gt; }
            else if (cu[k] == T) { if (pos_eq < 256) sl[pos_eq] = candK[qq * DCAP + idx]; ++pos_eq; }
        }
        __syncthreads();
    } else {
        unsigned T = NEGKEY;
        if (L > 256) {
            unsigned T0 = 0u, T1 = 0u;
            int par = 0;
            for (int bit = 31; bit >= 0; --bit) {
                const unsigned c0 = T0 | (1u << bit), c1 = T1 | (1u << bit);
                const unsigned cand = hf ? c1 : c0;
                int cn = 0;
#pragma unroll
                for (int i = 0; i < 64; ++i) cn += (u[i] >= cand) ? 1 : 0;
                cn += __shfl_xor(cn, 1); cn += __shfl_xor(cn, 2); cn += __shfl_xor(cn, 4); cn += __shfl_xor(cn, 8); cn += __shfl_xor(cn, 16);
                if (l31 == 0) cntx[par * 16 + w * 2 + hf] = cn;
                __syncthreads();
                int t0 = 0, t1 = 0;
#pragma unroll
                for (int ww = 0; ww < 8; ++ww) { t0 += cntx[par * 16 + ww * 2]; t1 += cntx[par * 16 + ww * 2 + 1]; }
                if (t0 >= 256) T0 = c0;
                if (t1 >= 256) T1 = c1;
                par ^= 1;
            }
            T = hf ? T1 : T0;
        }
        asm volatile("" : "+v"(T));
        int c2 = 0;
#pragma unroll
        for (int ii = 0; ii < 64; ++ii) c2 += (u[ii] > T ? 1 : 0) + (u[ii] == T ? 65536 : 0);
        int incl = c2;
#pragma unroll
        for (int o = 1; o < 32; o <<= 1) { const int t = __shfl_up(incl, o, 32); if (l31 >= o) incl += t; }
        if (l31 == 31) wtot[w * 2 + hf] = incl;
        __syncthreads();
        int base = 0, total = 0;
#pragma unroll
        for (int ww = 0; ww < 8; ++ww) { const int t = wtot[ww * 2 + hf]; total += t; if (ww < w) base += t; }
        const int excl = incl - c2;
        const int total_gt = total & 0xffff;
        int pos_gt = (base & 0xffff) + (excl & 0xffff);
        int pos_eq = total_gt + (base >> 16) + (excl >> 16);
        int* sl = sel + (slot + hf) * 256;
        asm volatile("" : "+v"(T));
#pragma unroll
        for (int ii = 0; ii < 64; ++ii) {
            const int key = (ii * 8 + w) * 32 + l31;
            if (u[ii] > T) { if (pos_gt < 256) sl[pos_gt] = key; ++pos_gt; }
            else if (u[ii] == T) { if (pos_eq < nsel) sl[pos_eq] = key; ++pos_eq; }
        }
        __syncthreads();
    }
}

DI void dsa_sparse(int tok, int qpos, int kbase, int nsel, int n, const int* sl, float* pw, const float* tabB,
                   const bf16_t* __restrict__ QB, const bf16_t* __restrict__ KB, const bf16_t* __restrict__ VB, bf16_t* __restrict__ OB) {
    int lane = threadIdx.x & 63; asm volatile("" : "+v"(lane));
    {
        const int row = lane & 15, kg = lane >> 4;
        bf16x8 qf[4];
#pragma unroll
        for (int ks = 0; ks < 4; ++ks) {
            u32x4 z = {0u, 0u, 0u, 0u};
            if (row < 4) z = *(const u32x4*)(QB + (size_t)tok * 1024 + (n * 4 + row) * 128 + ks * 32 + kg * 8);
            qf[ks] = __builtin_bit_cast(bf16x8, z);
        }
#pragma unroll 1
        for (int tb = 0; tb < 4; ++tb) {
            bf16x8 kf[4][4]; int keyv[4];
#pragma unroll
            for (int e = 0; e < 4; ++e) {
                const int j = (tb * 4 + e) * 16 + row;
                const int jj = j < nsel ? j : nsel - 1;
                keyv[e] = sl[jj];
                const bf16_t* kp = KB + (size_t)(kbase + keyv[e]) * 256 + n * 128 + kg * 8;
#pragma unroll
                for (int ks = 0; ks < 4; ++ks) kf[e][ks] = *(const bf16x8*)(kp + ks * 32);
            }
#pragma unroll
            for (int e = 0; e < 4; ++e) {
                const int j = (tb * 4 + e) * 16 + row;
                f32x4 d = {0.f, 0.f, 0.f, 0.f};
#pragma unroll
                for (int ks = 0; ks < 4; ++ks) d = MFMA16(qf[ks], kf[e][ks], d);
                int rel = keyv[e] - qpos; rel = rel < -128 ? -128 : rel;
                f32x4 v;
#pragma unroll
                for (int g = 0; g < 4; ++g) { const float x = d[g] * 0.08838834764831845f + tabB[(n * 4 + g) * 192 + rel + 128]; v[g] = (j < nsel) ? x : -1e30f; }
                if (kg == 0) *(f32x4*)(pw + j * 4) = v;
            }
        }
    }
    {
        f32x4 v[4];
#pragma unroll
        for (int e = 0; e < 4; ++e) v[e] = *(const f32x4*)(pw + (e * 64 + lane) * 4);
#pragma unroll
        for (int g = 0; g < 4; ++g) {
            float m = fmaxf(fmaxf(v[0][g], v[1][g]), fmaxf(v[2][g], v[3][g]));
#pragma unroll
            for (int o = 1; o < 64; o <<= 1) m = fmaxf(m, __shfl_xor(m, o));
            float sum = 0.f;
#pragma unroll
            for (int e = 0; e < 4; ++e) { v[e][g] = __expf(v[e][g] - m); sum += v[e][g]; }
            sum = wave_sum(sum);
            const float inv = 1.0f / sum;
#pragma unroll
            for (int e = 0; e < 4; ++e) v[e][g] *= inv;
        }
#pragma unroll
        for (int e = 0; e < 4; ++e) *(f32x4*)(pw + (e * 64 + lane) * 4) = v[e];
    }
    {
        const int ksub = lane >> 4, dc = lane & 15;
        float acc[4][8];
#pragma unroll
        for (int g = 0; g < 4; ++g)
#pragma unroll
            for (int e = 0; e < 8; ++e) acc[g][e] = 0.f;
        const bf16_t* vbase = VB + (size_t)kbase * 256 + n * 128 + dc * 8;
#pragma unroll 1
        for (int j0 = 0; j0 < nsel; j0 += 32) {
            u32x4 vv[8]; f32x4 pp[8];
#pragma unroll
            for (int i = 0; i < 8; ++i) {
                const int j = j0 + i * 4 + ksub;
                const int jj = j < nsel ? j : nsel - 1;
                vv[i] = *(const u32x4*)(vbase + (size_t)sl[jj] * 256);
                pp[i] = *(const f32x4*)(pw + jj * 4);
                if (j >= nsel) pp[i] = (f32x4){0.f, 0.f, 0.f, 0.f};
            }
#pragma unroll
            for (int i = 0; i < 8; ++i) {
                const float x0 = bflo(vv[i].x), x1 = bfhi(vv[i].x), x2 = bflo(vv[i].y), x3 = bfhi(vv[i].y), x4 = bflo(vv[i].z), x5 = bfhi(vv[i].z), x6 = bflo(vv[i].w), x7 = bfhi(vv[i].w);
#pragma unroll
                for (int g = 0; g < 4; ++g) {
                    const float p = pp[i][g];
                    acc[g][0] = __builtin_fmaf(p, x0, acc[g][0]); acc[g][1] = __builtin_fmaf(p, x1, acc[g][1]); acc[g][2] = __builtin_fmaf(p, x2, acc[g][2]); acc[g][3] = __builtin_fmaf(p, x3, acc[g][3]);
                    acc[g][4] = __builtin_fmaf(p, x4, acc[g][4]); acc[g][5] = __builtin_fmaf(p, x5, acc[g][5]); acc[g][6] = __builtin_fmaf(p, x6, acc[g][6]); acc[g][7] = __builtin_fmaf(p, x7, acc[g][7]);
                }
            }
        }
#pragma unroll
        for (int g = 0; g < 4; ++g) {
#pragma unroll
            for (int e = 0; e < 8; ++e) { float a = acc[g][e]; a += __shfl_xor(a, 16); a += __shfl_xor(a, 32); acc[g][e] = a; }
            if (ksub == 0) {
                u32x4 wv4; wv4.x = pk2(acc[g][0], acc[g][1]); wv4.y = pk2(acc[g][2], acc[g][3]); wv4.z = pk2(acc[g][4], acc[g][5]); wv4.w = pk2(acc[g][6], acc[g][7]);
                *(u32x4*)(OB + (size_t)tok * 1024 + (n * 4 + g) * 128 + dc * 8) = wv4;
            }
        }
    }
}

DI void dsa_phase(const Params& P, unsigned char* lds, int G, int c) {
    unsigned char* ws = P.ws;
    const bf16_t* QI = (const bf16_t*)(ws + WS_QI); const bf16_t* KI = (const bf16_t*)(ws + WS_KI); const float* WI = (const float*)(ws + WS_WI);
    const bf16_t* QB = (const bf16_t*)(ws + WS_QB); const bf16_t* KB = (const bf16_t*)(ws + WS_KB); const bf16_t* VB = (const bf16_t*)(ws + WS_VB);
    bf16_t* OB = (bf16_t*)(ws + WS_H) + (size_t)TT * 1024;
    float* tabB = (float*)(lds + D_TABB);
    for (int i = threadIdx.x; i < 8 * 192; i += NTHREADS) { const int hd = i / 192, rel = i % 192 - 128; tabB[i] = P.in[7][t5_bucket(rel) * 16 + 8 + hd]; }
    __syncthreads();
    const int w = __builtin_amdgcn_readfirstlane(threadIdx.x >> 6);
    const int nprompt = TP / 4, nsample = TS / 4;
    const int nmine = (nprompt - c + G - 1) / G, ps0 = (c + G / 2) % G;
    for (int k = 0; k < nmine + ((ps0 < nsample) ? (nsample - ps0 + G - 1) / G : 0); ++k) {
        const int it = (k < nmine) ? (c + k * G) : (nprompt + ps0 + (k - nmine) * G);
        int tok0, qpos0, kbase, L;
        if (it < TP / 4) { tok0 = 4 * it; qpos0 = tok0; kbase = 0; L = 64 * ((qpos0 >> 6) + 1); }
        else { const int p = it - TP / 4, b = p >> 3, t0 = (p & 7) * 4; tok0 = TP + 32 * b + t0; qpos0 = PAST + t0; kbase = TP + b * NKS; L = NKS; }
#pragma unroll 1
        for (int pr = 0; pr < 2; ++pr) dsa_select(tok0 + 2 * (pr & 1), kbase, L, 2 * (pr & 1), QI, KI, WI, lds);
        const int nsel = L < 256 ? L : 256;
        const int q = w >> 1, n = w & 1;
        dsa_sparse(tok0 + q, qpos0 + q, kbase, nsel, n, (const int*)(lds + D_SEL) + q * 256, (float*)(lds + D_PN) + w * 1024, tabB, QB, KB, VB, OB);
        __syncthreads();
    }
}

__global__ void __launch_bounds__(NTHREADS, 2) mega_fwd(Params P) {
    extern __shared__ __attribute__((aligned(16))) unsigned char lds[];
    const int G = gridDim.x, c = blockIdx.x;
    const int lo = P.ph_lo, hi = P.ph_hi;
    unsigned char* ws = P.ws;
    PG8_LAS unsigned char* ring = (PG8_LAS unsigned char*)lds;
#define IN_(k) (lo <= (k) && (k) < hi)
    if (threadIdx.x < 2) ((volatile LAS unsigned*)((PG8_LAS unsigned char*)lds + (LDS_BYTES - 64)))[threadIdx.x] = 0u;
    __syncthreads();
    if (threadIdx.x == 0) (void)xb_add((unsigned*)(P.ws + WS_BAR) + XB_XCNT(xb_xcc_id()), 1u);
#define SEAM_(k) do { if (IN_(k) && IN_((k) + 1)) { if (hi > 1000) cg::this_grid().sync();   { XcdBarrier xb_; xb_.bar = (unsigned*)(P.ws + WS_BAR); xb_.x = xb_xcc_id(); \
        xb_.st = (volatile LAS unsigned*)((PG8_LAS unsigned char*)lds + (LDS_BYTES - 64)); xcd_barrier(xb_); } } } while (0)
    if (IN_(0)) { for (int rep = 0; rep < (REP_PH == 0 ? 2 : 1); ++rep) { p0_prep(P, lds, G, c); __syncthreads(); } }
    SEAM_(0);
#ifndef SKIP_GEMM
    if (IN_(1)) for (int rep = 0; rep < (REP_PH == 1 ? 2 : 1); ++rep) {
        pg8::Gemm g{(const bf16_t*)(ws + WS_H), (const bf16_t*)(ws + WS_WT_IN), TT, NIN, DM, DM}; pg8::StaticOrder S; S.init(TT, NIN, G, c);
        EpiInProj E{P.out, ws, P.in[10], P.in[11], P.in[17], P.in[18], (float*)(lds + XCH_OFF)};
        pg8::gemm_phase<EpiInProj, pg8::StaticOrder, true, true>(ring, g, S, E);
    }
#endif
    SEAM_(1);
    if (IN_(2)) {
#ifndef SKIP_ATTN
        for (int rep = 0; rep < REP_ATTN; ++rep) { attn_a_phase(P, lds, G, c); __syncthreads(); }
#endif
#ifndef SKIP_DSA
        for (int rep = 0; rep < REP_DSA; ++rep) { dsa_phase(P, lds, G, c); }
#endif
    }
    SEAM_(2);
#ifndef SKIP_GEMM
    if (IN_(3)) for (int rep = 0; rep < (REP_PH == 3 ? 2 : 1); ++rep) {
        pg8::StaticOrder S; S.init(TT, DM, G, c);
        {
            pg8::Gemm g{(const bf16_t*)(ws + WS_H), (const bf16_t*)(ws + WS_WT_OA), TT, DM, 1024, 1024};
            EpiMerge<0> E{(const bf16_t*)(P.out + O_Y), (bf16_t*)(ws + WS_MERGED)};
            pg8::gemm_phase<EpiMerge<0>, pg8::StaticOrder, true, true>(ring, g, S, E);
        }
        __syncthreads();
        {
            pg8::Gemm g{(const bf16_t*)(ws + WS_H) + (size_t)TT * 1024, (const bf16_t*)(ws + WS_WT_OB), TT, DM, 1024, 1024};
            EpiMerge<1> E{(const bf16_t*)(P.out + O_Y), (bf16_t*)(ws + WS_MERGED)};
            pg8::gemm_phase<EpiMerge<1>, pg8::StaticOrder, true, true>(ring, g, S, E);
        }
    }
#endif
    SEAM_(3);
#ifndef SKIP_GEMM
    if (IN_(4)) for (int rep = 0; rep < (REP_PH == 4 ? 2 : 1); ++rep) {
        pg8::Gemm g{(const bf16_t*)(ws + WS_MERGED), (const bf16_t*)(ws + WS_WT_OUT), TT, DM, DM, DM}; pg8::StaticOrder S; S.init(TT, DM, G, c);
        EpiOut E{P.in[0], P.in[1], P.out + O_Y};
        pg8::gemm_phase<EpiOut, pg8::StaticOrder, true, true>(ring, g, S, E);
    }
#endif
    SEAM_(4);
    if (IN_(5)) { rmsnorm_rows(P.out + O_Y, P.out + O_Y + (size_t)TP * DM, P.in[22], (bf16_t*)(ws + WS_H), G, c); }
    SEAM_(5);
#ifndef SKIP_GEMM
    if (IN_(6)) for (int rep = 0; rep < (REP_PH == 6 ? 2 : 1); ++rep) {
        pg8::Gemm g{(const bf16_t*)(ws + WS_H), (const bf16_t*)(ws + WS_WT_FF1), TT, DFF, DM, DM}; pg8::StaticOrder S; S.init(TT, DFF, G, c);
        EpiFF1 E{(bf16_t*)(ws + WS_U)};
        pg8::gemm_phase<EpiFF1, pg8::StaticOrder, true, true>(ring, g, S, E);
    }
#endif
    SEAM_(6);
#ifndef SKIP_GEMM
    if (IN_(7)) {
        pg8::StaticOrder S; S.init(TT, DM, G, c);
        const int nunits = (TT / 256) * (DM / 256), rounds = nunits / G, left = nunits - rounds * G;
        {
            pg8::Gemm g{(const bf16_t*)(ws + WS_U), (const bf16_t*)(ws + WS_WT_FF2), TT, DM, DFF, DFF};
            OrderRounds SR{S, rounds};
            EpiFF2 E{P.out + O_Y};
            pg8::gemm_phase<EpiFF2, OrderRounds, true, true>(ring, g, SR, E);
        }
        for (int mi = c; mi < left * 16; mi += G) {
            const int r = mi % left, sl = mi / left;
            __syncthreads();
            pg8::Gemm g{(const bf16_t*)(ws + WS_U) + sl * 512, (const bf16_t*)(ws + WS_WT_FF2) + sl * 512, TT, DM, 512, DFF};
            OrderOne SO{S, rounds * G + r};
            EpiFF2Part E{(float*)(ws + WS_H) + (size_t)mi * 65536};
            pg8::gemm_phase<EpiFF2Part, OrderOne, true, true>(ring, g, SO, E);
        }
    }
    SEAM_(7);
    if (IN_(8)) {
        pg8::StaticOrder S; S.init(TT, DM, G, c);
        const int nunits = (TT / 256) * (DM / 256), rounds = nunits / G, left = nunits - rounds * G;
        const float* part = (const float*)(ws + WS_H);
        for (int t = c * NTHREADS + (int)threadIdx.x; t < left * 16384; t += G * NTHREADS) {
            const int r = t >> 14, e4 = t & 16383, rl = e4 >> 6, cl = (e4 & 63) * 4;
            pg8::Unit u; S.at((long)(rounds * G + r), u);
            f32x4 a = {0.f, 0.f, 0.f, 0.f};
#pragma unroll
            for (int sl = 0; sl < 16; ++sl) a += *(const f32x4*)(part + (size_t)(sl * left + r) * 65536 + rl * 256 + cl);
            float* yo = P.out + O_Y + (size_t)(u.pm * 256 + rl) * DM + u.pn * 256 + cl;
            *(f32x4*)yo = *(const f32x4*)yo + a;
        }
    }
#endif
}

extern "C" void kernel_launch(void* const* d_in, const int* in_sizes, int n_in, void* d_out, int out_size, void* d_ws, size_t ws_size, hipStream_t stream) {
    static int grid = 0;
    if (grid == 0) {
        if (n_in != 25 || (size_t)out_size != O_END || ws_size < WS_END) {
            fprintf(stderr, "kernel_launch: unexpected problem: n_in %d out_size %d (want %zu) ws %zu (want %zu)\n", n_in, out_size, (size_t)O_END, ws_size, (size_t)WS_END);
            grid = -1; return;
        }
        int dev = 0, cus = 0, per_cu = 0;
        hipGetDevice(&dev);
        hipDeviceGetAttribute(&cus, hipDeviceAttributeMultiprocessorCount, dev);
        hipFuncSetAttribute((const void*)mega_fwd, hipFuncAttributeMaxDynamicSharedMemorySize, LDS_BYTES);
        hipOccupancyMaxActiveBlocksPerMultiprocessor(&per_cu, (const void*)mega_fwd, NTHREADS, LDS_BYTES);
        if (per_cu < 1) { fprintf(stderr, "kernel_launch: occupancy query says %d blocks per CU\n", per_cu); per_cu = 1; }
        (void)hipGetLastError();
        grid = cus * per_cu;
    }
    if (grid < 0) return;
    if (hipMemsetAsync((char*)d_ws + WS_BAR, 0, WS_BAR_BYTES, stream) != hipSuccess) { fprintf(stderr, "kernel_launch: memset of the barrier words failed\n"); return; }
    Params p{};
    for (int i = 0; i < 25; ++i) p.in[i] = (const float*)d_in[i];
    p.out = (float*)d_out; p.ws = (unsigned char*)d_ws;
#if N_LAUNCH_MODE == 1
    p.ph_lo = 0; p.ph_hi = 9;
    void* args[] = {&p};
    hipError_t e = hipLaunchCooperativeKernel((const void*)mega_fwd, dim3(grid), dim3(NTHREADS), args, LDS_BYTES, stream);
    if (e != hipSuccess) fprintf(stderr, "cooperative launch failed: %s (grid %d)\n", hipGetErrorString(e), grid);
#else
    for (int ph = 0; ph < 9; ++ph) {
        p.ph_lo = ph; p.ph_hi = ph + 1;
        hipLaunchKernelGGL(mega_fwd, dim3(grid), dim3(NTHREADS), LDS_BYTES, stream, p);
    }
#endif
}
```
